# Optimizing an MI355X kernel written in HIP

```python
import math
import jax, jax.numpy as jnp
from jax import lax
import numpy as np

D_MODEL = 2048
BATCH = 1
SEQ = 8192
DEPTH = 4

N_MIXERS = 2
N_HEADS = 16
HEAD_DIM = 128
BRANCH = N_HEADS * HEAD_DIM
Q_RANK = 512
KV_RANK = 256
IDX_HEADS = 16
IDX_DIM = 128
TOPK_MAX = 256
DSA_QBLOCK = 128
MOBA_BLOCK = 256
MOBA_TOPK = 3
MOBA_QCHUNK = 32
LN_EPS = 1e-5
DN_ALPHA = float((2 * DEPTH) ** 0.25)
DN_BETA = float((8 * DEPTH) ** -0.25)
N_DSA = (DEPTH + 1) // 2
N_MOBA = DEPTH // 2
DSA_IN = Q_RANK + KV_RANK + IDX_DIM + IDX_HEADS + BRANCH
DSA_SPLITS = (Q_RANK, Q_RANK + KV_RANK, Q_RANK + KV_RANK + IDX_DIM, Q_RANK + KV_RANK + IDX_DIM + IDX_HEADS)
MOBA_IN = 4 * BRANCH

kernel_name = "hybrid_dsa_moba_deepnorm_adaln"


def alibi_slopes():
    return jnp.asarray(2.0 ** (-8.0 * np.arange(1, N_HEADS + 1) / N_HEADS), dtype=jnp.float32)


def layer_norm(x, g, b):
    xf = x.astype(jnp.float32)
    mu = jnp.mean(xf, axis=-1, keepdims=True)
    var = jnp.mean(jnp.square(xf - mu), axis=-1, keepdims=True)
    y = (xf - mu) * lax.rsqrt(var + LN_EPS)
    return (y * g.astype(jnp.float32) + b.astype(jnp.float32)).astype(x.dtype)


def rms_norm(x, g):
    xf = x.astype(jnp.float32)
    y = xf * lax.rsqrt(jnp.mean(jnp.square(xf), axis=-1, keepdims=True) + LN_EPS)
    return (y * g.astype(jnp.float32)).astype(x.dtype)


def dsa_mixer(h, w_in, g_q, g_kv, w_uq, w_qi, w_uk, w_uv, w_o):
    B, S, _ = h.shape
    proj = h @ w_in
    c_q, c_kv, k_idx, w_idx, gate = jnp.split(proj, DSA_SPLITS, axis=-1)
    c_q = rms_norm(c_q, g_q)
    c_kv = rms_norm(c_kv, g_kv)
    q = (c_q @ w_uq).reshape(B, S, N_HEADS, HEAD_DIM)
    q_lat = jnp.einsum('bshd,hdc->bshc', q, w_uk)
    q_idx = (c_q @ w_qi).reshape(B, S, IDX_HEADS, IDX_DIM).astype(jnp.float32)
    k_idx = k_idx.astype(jnp.float32)
    w_idx = w_idx.astype(jnp.float32) * (IDX_HEADS ** -0.5)
    topk = min(TOPK_MAX, S // 4)
    slopes = alibi_slopes()
    scale = HEAD_DIM ** -0.5
    s_pos = jnp.arange(S, dtype=jnp.int32)
    b_idx = jnp.arange(B)[:, None, None]

    def block(qb):
        start = qb * DSA_QBLOCK
        qi = lax.dynamic_slice_in_dim(q_idx, start, DSA_QBLOCK, axis=1)
        wi = lax.dynamic_slice_in_dim(w_idx, start, DSA_QBLOCK, axis=1)
        ql = lax.dynamic_slice_in_dim(q_lat, start, DSA_QBLOCK, axis=1)
        t = start + jnp.arange(DSA_QBLOCK, dtype=jnp.int32)
        logits = jnp.einsum('bqhd,bsd->bhqs', qi, k_idx) * (IDX_DIM ** -0.5)
        score = jnp.einsum('bhqs,bqh->bqs', jax.nn.relu(logits), wi)
        causal = s_pos[None, :] <= t[:, None]
        score = jnp.where(causal[None], score, -jnp.inf)
        _, sel = lax.top_k(score, topk)
        kv_sel = c_kv[b_idx, sel]
        att = jnp.einsum('bqhc,bqkc->bhqk', ql, kv_sel).astype(jnp.float32) * scale
        dist = (t[None, :, None] - sel)[:, None]
        att = att - slopes[None, :, None, None] * dist.astype(jnp.float32)
        att = jnp.where(dist >= 0, att, -jnp.inf)
        p = jax.nn.softmax(att, axis=-1).astype(kv_sel.dtype)
        return jnp.einsum('bhqk,bqkc->bqhc', p, kv_sel)

    o_lat = lax.map(block, jnp.arange(S // DSA_QBLOCK))
    o_lat = o_lat.transpose(1, 0, 2, 3, 4).reshape(B, S, N_HEADS, KV_RANK)
    o = jnp.einsum('bshc,hcd->bshd', o_lat, w_uv).reshape(B, S, BRANCH)
    return (o * jax.nn.silu(gate)) @ w_o


def moba_mixer(h, w_in, w_o):
    B, S, _ = h.shape
    proj = h @ w_in
    q, k, v, gate = jnp.split(proj, 4, axis=-1)
    q = q.reshape(B, S, N_HEADS, HEAD_DIM).transpose(0, 2, 1, 3)
    k = k.reshape(B, S, N_HEADS, HEAD_DIM).transpose(0, 2, 1, 3)
    v = v.reshape(B, S, N_HEADS, HEAD_DIM).transpose(0, 2, 1, 3)
    nb = -(-S // MOBA_BLOCK)
    pad = nb * MOBA_BLOCK - S
    kp = jnp.pad(k, ((0, 0), (0, 0), (0, pad), (0, 0)))
    vp = jnp.pad(v, ((0, 0), (0, 0), (0, pad), (0, 0)))
    kb = kp.reshape(B, N_HEADS, nb, MOBA_BLOCK, HEAD_DIM)
    vb = vp.reshape(B, N_HEADS, nb, MOBA_BLOCK, HEAD_DIM)
    k_mean = jnp.mean(kb.astype(jnp.float32), axis=3)
    k_sel = max(1, min(MOBA_TOPK, nb - 1))
    slopes = alibi_slopes()[None, :, None, None]
    scale = HEAD_DIM ** -0.5
    blk_ids = jnp.arange(nb, dtype=jnp.int32)
    bi = jnp.arange(B)[:, None, None, None]
    hi = jnp.arange(N_HEADS)[None, :, None, None]
    in_blk = jnp.arange(MOBA_BLOCK, dtype=jnp.int32)

    def chunk(ci):
        start = ci * MOBA_QCHUNK
        qc = lax.dynamic_slice_in_dim(q, start, MOBA_QCHUNK, axis=2)
        t = start + jnp.arange(MOBA_QCHUNK, dtype=jnp.int32)
        own = start // MOBA_BLOCK
        g = jnp.einsum('bhqd,bhnd->bhqn', qc.astype(jnp.float32), k_mean)
        g = jnp.where(blk_ids < own, g, -jnp.inf)
        _, sel = lax.top_k(g, k_sel)
        ksel = kb[bi, hi, sel]
        vsel = vb[bi, hi, sel]
        s_past = jnp.einsum('bhqd,bhqnkd->bhqnk', qc, ksel).astype(jnp.float32) * scale
        pos_past = sel[..., None] * MOBA_BLOCK + in_blk
        d_past = (t[None, None, :, None, None] - pos_past).astype(jnp.float32)
        s_past = s_past - slopes[..., None] * d_past
        s_past = jnp.where((sel < own)[..., None], s_past, -jnp.inf)
        s_past = s_past.reshape(B, N_HEADS, MOBA_QCHUNK, k_sel * MOBA_BLOCK)
        k_own = lax.dynamic_slice_in_dim(kp, own * MOBA_BLOCK, MOBA_BLOCK, axis=2)
        v_own = lax.dynamic_slice_in_dim(vp, own * MOBA_BLOCK, MOBA_BLOCK, axis=2)
        s_own = jnp.einsum('bhqd,bhkd->bhqk', qc, k_own).astype(jnp.float32) * scale
        d_own = t[:, None] - (own * MOBA_BLOCK + in_blk)[None, :]
        s_own = s_own - slopes * d_own.astype(jnp.float32)[None, None]
        s_own = jnp.where((d_own >= 0)[None, None], s_own, -jnp.inf)
        p = jax.nn.softmax(jnp.concatenate([s_past, s_own], axis=-1), axis=-1).astype(v.dtype)
        p_past = p[..., :k_sel * MOBA_BLOCK]
        p_own = p[..., k_sel * MOBA_BLOCK:]
        vsel = vsel.reshape(B, N_HEADS, MOBA_QCHUNK, k_sel * MOBA_BLOCK, HEAD_DIM)
        return (jnp.einsum('bhqm,bhqmd->bhqd', p_past, vsel)
                + jnp.einsum('bhqk,bhkd->bhqd', p_own, v_own))

    out = lax.map(chunk, jnp.arange(S // MOBA_QCHUNK))
    out = out.transpose(1, 0, 3, 2, 4).reshape(B, S, BRANCH)
    return (out * jax.nn.silu(gate)) @ w_o


def setup_inputs(seed: int = 0) -> dict:
    key = jax.random.key(seed)
    ks = jax.random.split(key, 20)
    f32 = jnp.float32
    nrm = lambda k, shape, s: jax.random.normal(k, shape, f32) * s
    return {
        "x": nrm(ks[0], (BATCH, SEQ, D_MODEL), 1.0),
        "c": nrm(ks[1], (BATCH, D_MODEL), 1.0),
        "ada_w": nrm(ks[2], (DEPTH, D_MODEL, 3 * D_MODEL), D_MODEL ** -0.5),
        "ada_b": nrm(ks[3], (DEPTH, 3 * D_MODEL), 0.02),
        "ln_g": 1.0 + nrm(ks[4], (DEPTH, D_MODEL), 0.02),
        "ln_b": nrm(ks[5], (DEPTH, D_MODEL), 0.02),
        "dsa_w_in": nrm(ks[6], (N_DSA, D_MODEL, DSA_IN), D_MODEL ** -0.5),
        "dsa_g_q": 1.0 + nrm(ks[7], (N_DSA, Q_RANK), 0.02),
        "dsa_g_kv": 1.0 + nrm(ks[8], (N_DSA, KV_RANK), 0.02),
        "dsa_w_uq": nrm(ks[9], (N_DSA, Q_RANK, BRANCH), Q_RANK ** -0.5),
        "dsa_w_qi": nrm(ks[10], (N_DSA, Q_RANK, IDX_HEADS * IDX_DIM), Q_RANK ** -0.5),
        "dsa_w_uk": nrm(ks[11], (N_DSA, N_HEADS, HEAD_DIM, KV_RANK), HEAD_DIM ** -0.5),
        "dsa_w_uv": nrm(ks[12], (N_DSA, N_HEADS, KV_RANK, HEAD_DIM), KV_RANK ** -0.5),
        "dsa_w_o": nrm(ks[13], (N_DSA, BRANCH, D_MODEL), DN_BETA * BRANCH ** -0.5),
        "moba_w_in": nrm(ks[14], (N_MOBA, D_MODEL, MOBA_IN), D_MODEL ** -0.5),
        "moba_w_o": nrm(ks[15], (N_MOBA, BRANCH, D_MODEL), DN_BETA * BRANCH ** -0.5),
    }


def reference(x, c, ada_w, ada_b, ln_g, ln_b, dsa_w_in, dsa_g_q, dsa_g_kv, dsa_w_uq, dsa_w_qi,
              dsa_w_uk, dsa_w_uv, dsa_w_o, moba_w_in, moba_w_o):
    c_act = jax.nn.silu(c)
    for i in range(DEPTH):
        mod = c_act @ ada_w[i] + ada_b[i]
        shift, scl, gate = jnp.split(mod, 3, axis=-1)
        h = x * (1.0 + scl[:, None, :]) + shift[:, None, :]
        j = i // N_MIXERS
        if i % N_MIXERS == 0:
            y = dsa_mixer(h, dsa_w_in[j], dsa_g_q[j], dsa_g_kv[j], dsa_w_uq[j], dsa_w_qi[j],
                          dsa_w_uk[j], dsa_w_uv[j], dsa_w_o[j])
        else:
            y = moba_mixer(h, moba_w_in[j], moba_w_o[j])
        x = layer_norm(DN_ALPHA * x + gate[:, None, :] * y, ln_g[i], ln_b[i])
    return x
```

```cpp
#include <hip/hip_runtime.h>
#include <hip/hip_cooperative_groups.h>
#include <cstdio>
#include <cstdint>
namespace cg = cooperative_groups;

#ifndef MK_ONE_LAUNCH
#define MK_ONE_LAUNCH 1
#endif
#ifndef MK_ONLY
#define MK_ONLY -1
#endif
#define EN(k) (MK_ONLY < 0 || MK_ONLY == (k))
#ifndef MK_CHECK
#define MK_CHECK 0
#endif
#ifndef MK_CHECK_STAGE
#define MK_CHECK_STAGE -1
#endif
constexpr int DBG_WORDS = 64;

#define LAS __attribute__((address_space(3)))
typedef unsigned short bf16_t;
typedef short bf16x8 __attribute__((ext_vector_type(8)));
typedef float f32x4 __attribute__((ext_vector_type(4)));
typedef float f32x16 __attribute__((ext_vector_type(16)));
typedef unsigned u32x4 __attribute__((ext_vector_type(4)));
typedef unsigned u32x2 __attribute__((ext_vector_type(2)));
typedef __bf16 bf2_t __attribute__((ext_vector_type(2)));

constexpr int S = 8192, D = 2048, NH = 16, HD = 128, QR = 512, KVR = 256, DEPTH = 4;
constexpr int DSA_IN = 2960, DSA_INP = 3072, MOBA_IN = 8192;
constexpr float LN_EPS = 1e-5f;
constexpr float DN_ALPHA = 1.6817928305074290f;
constexpr float QK_SCALE = 0.088388347648318440f;
constexpr float LOG2E = 1.4426950408889634f;

constexpr size_t MiB = 1u << 20;
constexpr size_t WS_CTL = 0;
constexpr size_t WS_MODP = 1 * MiB;
constexpr size_t WS_MOD = 3 * MiB;
constexpr size_t WS_KMEAN = 3 * MiB + 512 * 1024;
constexpr size_t WS_SSQ = 4 * MiB;
constexpr size_t WS_WIDX = 5 * MiB;
constexpr size_t WS_WGT = 8 * MiB;
constexpr size_t WD_WIN = 0, WD_W2 = (size_t)DSA_INP * D * 2, WD_WUV = WD_W2 + (size_t)6144 * 512 * 2, WD_WO = WD_WUV + (size_t)2048 * 512 * 2, WD_SIZE = WD_WO + (size_t)D * D * 2;
constexpr size_t WM_WIN = 0, WM_WO = (size_t)MOBA_IN * D * 2, WM_SIZE = WM_WO + (size_t)D * D * 2;
constexpr size_t WS_WD0 = WS_WGT, WS_WM0 = WS_WGT + 2 * WD_SIZE;
constexpr size_t WS_X1 = WS_WM0 + 2 * WM_SIZE;
constexpr size_t WS_Z = WS_X1 + 64 * MiB;
constexpr size_t WS_HB = WS_Z + 64 * MiB;
constexpr size_t WS_GACT = WS_HB + 32 * MiB;
constexpr size_t WS_SG = WS_GACT + 32 * MiB;
constexpr size_t WS_U = WS_SG + 32 * MiB;
constexpr size_t WU_CQ = WS_U, WU_CKV = WU_CQ + 8 * MiB, WU_CKVN = WU_CKV + 8 * MiB, WU_KIDX = WU_CKVN + 4 * MiB, WU_QLAT = WU_KIDX + 2 * MiB,
                 WU_QIDX = WU_QLAT + 64 * MiB, WU_SC = WU_QIDX + 32 * MiB, WU_OLAT = WU_SC + 128 * MiB, WU_DEND = WU_OLAT + 64 * MiB;
constexpr size_t WU_Q = WS_U, WU_K = WU_Q + 32 * MiB, WU_V = WU_K + 32 * MiB, WU_MEND = WU_V + 32 * MiB;
constexpr size_t WS_END = WU_DEND;
static_assert(WU_K == WU_Q + 32 * MiB && WU_V == WU_Q + 64 * MiB, "Q|K|V spacing");
static_assert(WD_SIZE == 28 * MiB && WM_SIZE == 40 * MiB && WS_X1 == 144 * MiB, "ws map");

constexpr int LDS_BYTES = 147456;

struct Args {
    const float* in[16];
    float* out;
    unsigned char* ws;
    int ph_lo, ph_hi;
};
typedef const __attribute__((address_space(4))) Args& KA;

__device__ __forceinline__ unsigned f2bf(float f) { unsigned u = __builtin_bit_cast(unsigned, f); return (u + 0x7fffu + ((u >> 16) & 1u)) >> 16; }
__device__ __forceinline__ unsigned pk2(float lo, float hi) { return f2bf(lo) | (f2bf(hi) << 16); }
__device__ __forceinline__ unsigned cvt_pk_bf16(float lo, float hi) { unsigned r; asm volatile("v_cvt_pk_bf16_f32 %0, %1, %2" : "=v"(r) : "v"(lo), "v"(hi)); return r; }
__device__ __forceinline__ float bf_lo(unsigned w) { return __builtin_bit_cast(float, w << 16); }
__device__ __forceinline__ float bf_hi(unsigned w) { return __builtin_bit_cast(float, w & 0xffff0000u); }
__device__ __forceinline__ float dot2bf(unsigned a, unsigned b, float c) { return __builtin_amdgcn_fdot2_f32_bf16(__builtin_bit_cast(bf2_t, a), __builtin_bit_cast(bf2_t, b), c, false); }
__device__ __forceinline__ float silu_f(float x) { return x * __builtin_amdgcn_rcpf(1.0f + __builtin_amdgcn_exp2f(-x * LOG2E)); }
__device__ __forceinline__ float wave_sum(float v) {
#pragma unroll
    for (int o = 1; o < 64; o <<= 1) v += __shfl_xor(v, o);
    return v;
}
__device__ __forceinline__ float wave_max(float v) {
#pragma unroll
    for (int o = 1; o < 64; o <<= 1) v = fmaxf(v, __shfl_xor(v, o));
    return v;
}
#define LDS_WAIT() asm volatile("s_waitcnt lgkmcnt(0)" ::: "memory")

namespace pg8 {
constexpr int BM = 256, BK = 64, HALF = 128, HTB = HALF * BK * 2, STAGE_BYTES = 8 * HTB, NXCD = 8, WGM = 8;
__host__ __device__ __forceinline__ int lds_byte(int r, int c) { const int st = (r >> 4) * 2 + (c >> 5), rr = r & 15, cc = c & 31, ob = rr * 64 + cc * 2; return st * 1024 + (ob ^ (((ob >> 9) & 1) << 5)); }
__host__ __device__ __forceinline__ void stage_rc(int b, int& R, int& C) { const int st = b / 1024, sb = b % 1024, swz = sb ^ (((sb >> 9) & 1) << 5); R = (st >> 1) * 16 + swz / 64; C = (st & 1) * 32 + (swz % 64) / 2; }
__host__ __device__ __forceinline__ int perm32(int rho) { const int n = rho >> 4, i = rho & 15; return 8 * (i >> 2) + 4 * n + (i & 3); }

struct Unit { int pm, pn; };
struct Gemm { const bf16_t* A; const bf16_t* Bt; int M, N, K, lda, ldb; long a_pn_off; };

struct StaticOrder {
    int nM, nN, nwg, G, c;
    __host__ __device__ void init(int M, int N, int G_, int c_) { nM = M / BM; nN = N / BM; nwg = nM * nN; G = G_; c = c_; }
    __host__ __device__ bool next(int i, Unit& u) const {
        const long L = (long)i * G + c; if (L >= nwg) return false;
        int wgid = (int)L; { const int q = nwg / NXCD, r = nwg % NXCD, xcd = wgid % NXCD, off = wgid / NXCD; wgid = (xcd < r ? xcd * (q + 1) : r * (q + 1) + (xcd - r) * q) + off; }
        const int nig = WGM * nN, gid = wgid / nig, fm = gid * WGM, gsz = (nM - fm) < WGM ? (nM - fm) : WGM;
        u.pm = fm + ((wgid % nig) % gsz); u.pn = (wgid % nig) / gsz; return true;
    }
};

template <class Epi>
__device__ __forceinline__ void gemm_phase(LAS unsigned char* lds, const int tid, const Gemm g, const StaticOrder& S, const Epi& E) {
    const int wid = __builtin_amdgcn_readfirstlane(tid >> 6), lane = tid & 63, wr = wid >> 2, wc = wid & 3, fr = lane & 15, fq = lane >> 4;
    const int K = g.K, nt = K / BK;
    unsigned voffA[2], voffB[2];
#pragma unroll
    for (int i = 0; i < 2; ++i) { int R, C; stage_rc(tid * 16 + i * 8192, R, C); const int Rb = Epi::PERM ? ((R & ~31) + perm32(R & 31)) : R;
        voffA[i] = (unsigned)(R * g.lda + C) * 2u; voffB[i] = (unsigned)(Rb * g.ldb + C) * 2u; }
    const size_t kstep = (size_t)(BK * 2);
    const size_t hstepA = (size_t)HALF * g.lda * 2, hstepB = (size_t)HALF * g.ldb * 2;
    const size_t tstepA = 2 * hstepA, tstepB = 2 * hstepB;
    const size_t pnA = (size_t)g.a_pn_off * 2;
    const unsigned ldsw = (unsigned)wid * 1024u;
    const int aoff = lds_byte(wr * 64 + fr, fq * 8), boff = lds_byte(wc * 32 + fr, fq * 8);
#define PG8_SA(b, h) (((b) * 2 + (h)) * HTB)
#define PG8_SB(b, h) ((4 + (b) * 2 + (h)) * HTB)
#define PG8_STAGE(bufoff, gbase, voff) do { _Pragma("unroll") for (int _i = 0; _i < 2; ++_i) \
        __builtin_amdgcn_global_load_lds((const unsigned*)((const char*)(gbase) + (voff)[_i]), (LAS unsigned*)(lds + (bufoff) + ldsw + _i * 8192), 16, 0, 0); } while (0)
#define PG8_LDA(dst, b, h) do { _Pragma("unroll") for (int m = 0; m < 4; ++m) _Pragma("unroll") for (int k = 0; k < 2; ++k) dst[m][k] = *(const LAS bf16x8*)(lds + PG8_SA(b, h) + aoff + m * 2048 + k * 1024); } while (0)
#define PG8_LDB(dst, b, h) do { _Pragma("unroll") for (int n = 0; n < 2; ++n) _Pragma("unroll") for (int k = 0; k < 2; ++k) dst[n][k] = *(const LAS bf16x8*)(lds + PG8_SB(b, h) + boff + n * 2048 + k * 1024); } while (0)
#define PG8_MMA(ai, bj, At, Bt) do { __builtin_amdgcn_s_setprio(1); _Pragma("unroll") for (int m = 0; m < 4; ++m) _Pragma("unroll") for (int n = 0; n < 2; ++n) _Pragma("unroll") for (int k = 0; k < 2; ++k) \
        acc[ai][bj][m][n] = __builtin_amdgcn_mfma_f32_16x16x32_bf16(Bt[n][k], At[m][k], acc[ai][bj][m][n], 0, 0, 0); __builtin_amdgcn_s_setprio(0); } while (0)
#define PG8_WAIT_V(n) asm volatile("s_waitcnt vmcnt(" #n ")" ::: "memory")
#define PG8_WAIT_L(n) asm volatile("s_waitcnt lgkmcnt(" #n ")" ::: "memory")
#define PG8_BAR __builtin_amdgcn_s_barrier()
#define PG8_SCHED __builtin_amdgcn_sched_barrier(0)
    Unit cur, nxt; int ui = 0;
    if (!S.next(0, cur)) return;
    f32x4 acc[2][2][4][2];
#pragma unroll
    for (int a = 0; a < 2; ++a)
#pragma unroll
        for (int b = 0; b < 2; ++b)
#pragma unroll
            for (int m = 0; m < 4; ++m)
#pragma unroll
                for (int n = 0; n < 2; ++n) acc[a][b][m][n] = (f32x4){0.f, 0.f, 0.f, 0.f};
    bf16x8 At[4][2], B0[2][2], B1[2][2];
    const char* cA = (const char*)g.A + (size_t)cur.pm * tstepA + (size_t)cur.pn * pnA; const char* cB = (const char*)g.Bt + (size_t)cur.pn * tstepB;
    PG8_STAGE(PG8_SB(0, 0), cB, voffB); PG8_STAGE(PG8_SB(0, 1), cB + hstepB, voffB); PG8_STAGE(PG8_SA(0, 0), cA, voffA); PG8_STAGE(PG8_SA(0, 1), cA + hstepA, voffA);
    if (wr == 1) PG8_BAR;
    PG8_WAIT_V(2); PG8_BAR;
    PG8_STAGE(PG8_SB(1, 0), cB + kstep, voffB); PG8_STAGE(PG8_SA(1, 0), cA + kstep, voffA); PG8_STAGE(PG8_SB(1, 1), cB + hstepB + kstep, voffB);
    PG8_WAIT_V(6); PG8_BAR;
    for (;;) {
        const bool has_next = S.next(ui + 1, nxt);
        const char* nA = has_next ? (const char*)g.A + (size_t)nxt.pm * tstepA + (size_t)nxt.pn * pnA : cA; const char* nB = has_next ? (const char*)g.Bt + (size_t)nxt.pn * tstepB : cB;
        for (int t = 0; t < nt; t += 2) {
            const bool last = (t == nt - 2);
            const char* a1 = cA + (size_t)(t + 1) * kstep;
            const char* a2 = last ? nA : cA + (size_t)(t + 2) * kstep; const char* b2 = last ? nB : cB + (size_t)(t + 2) * kstep;
            const char* a3 = a2 + kstep; const char* b3 = b2 + kstep;
            PG8_LDB(B0, 0, 0); PG8_LDB(B1, 0, 1); PG8_SCHED; PG8_LDA(At, 0, 0); PG8_STAGE(PG8_SA(1, 1), a1 + hstepA, voffA);
            PG8_WAIT_V(8); PG8_WAIT_L(0); PG8_BAR; PG8_MMA(0, 0, At, B0); PG8_MMA(0, 1, At, B1); PG8_BAR; PG8_SCHED;
            PG8_LDA(At, 0, 1); PG8_STAGE(PG8_SB(0, 0), b2, voffB); PG8_STAGE(PG8_SB(0, 1), b2 + hstepB, voffB); PG8_STAGE(PG8_SA(0, 0), a2, voffA);
            PG8_WAIT_V(8); PG8_WAIT_L(0); PG8_BAR; PG8_MMA(1, 0, At, B0); PG8_MMA(1, 1, At, B1); PG8_BAR; PG8_SCHED;
            PG8_LDB(B0, 1, 0); PG8_LDB(B1, 1, 1); PG8_SCHED; PG8_LDA(At, 1, 0); PG8_STAGE(PG8_SA(0, 1), a2 + hstepA, voffA);
            PG8_WAIT_V(8); PG8_WAIT_L(0); PG8_BAR; PG8_MMA(0, 0, At, B0); PG8_MMA(0, 1, At, B1); PG8_BAR; PG8_SCHED;
            PG8_LDA(At, 1, 1); PG8_STAGE(PG8_SB(1, 0), b3, voffB); PG8_STAGE(PG8_SB(1, 1), b3 + hstepB, voffB); PG8_STAGE(PG8_SA(1, 0), a3, voffA);
            PG8_WAIT_V(8); PG8_WAIT_L(0); PG8_BAR; PG8_MMA(1, 0, At, B0); PG8_MMA(1, 1, At, B1); PG8_BAR; PG8_SCHED;
        }
        if (wr == 0) PG8_BAR;
        E(acc, cur, wr, wc, fr, fq);
        if (!has_next) break;
#pragma unroll
        for (int a = 0; a < 2; ++a)
#pragma unroll
            for (int b = 0; b < 2; ++b)
#pragma unroll
                for (int m = 0; m < 4; ++m)
#pragma unroll
                    for (int n = 0; n < 2; ++n) acc[a][b][m][n] = (f32x4){0.f, 0.f, 0.f, 0.f};
        cur = nxt; cA = nA; cB = nB; ++ui;
        if (wr == 1) PG8_BAR;
    }
    PG8_WAIT_V(0);
    PG8_BAR;
#undef PG8_SA
#undef PG8_SB
#undef PG8_STAGE
#undef PG8_LDA
#undef PG8_LDB
#undef PG8_MMA
#undef PG8_WAIT_V
#undef PG8_WAIT_L
#undef PG8_BAR
#undef PG8_SCHED
}

__device__ __forceinline__ u32x4 pack8(f32x4 v0, f32x4 v1) { u32x4 w; w.x = cvt_pk_bf16(v0[0], v0[1]); w.y = cvt_pk_bf16(v0[2], v0[3]); w.z = cvt_pk_bf16(v1[0], v1[1]); w.w = cvt_pk_bf16(v1[2], v1[3]); return w; }

struct EpiDsaIn {
    static constexpr bool PERM = true;
    bf16_t* CQ; float* CKV; bf16_t* KIDX; float* WIDX; bf16_t* SG; float* SSQ;
    __device__ __forceinline__ void operator()(const f32x4 (&acc)[2][2][4][2], const Unit& u, int wr, int wc, int fr, int fq) const {
        const int row0 = u.pm * BM + wr * 64 + fr, pn = u.pn, cw = wc * 32 + 8 * fq;
        if (pn < 3) {
#pragma unroll
            for (int ai = 0; ai < 2; ++ai)
#pragma unroll
                for (int m = 0; m < 4; ++m) { const int row = row0 + ai * HALF + m * 16; float s = 0.f;
#pragma unroll
                    for (int bj = 0; bj < 2; ++bj) { const f32x4 v0 = acc[ai][bj][m][0], v1 = acc[ai][bj][m][1];
                        s += (v0[0] * v0[0] + v0[1] * v0[1]) + (v0[2] * v0[2] + v0[3] * v0[3]) + (v1[0] * v1[0] + v1[1] * v1[1]) + (v1[2] * v1[2] + v1[3] * v1[3]);
                        if (pn < 2) *(u32x4*)(CQ + (size_t)row * QR + pn * 256 + bj * HALF + cw) = pack8(v0, v1);
                        else { float* p = CKV + (size_t)row * KVR + bj * HALF + cw; *(f32x4*)p = v0; *(f32x4*)(p + 4) = v1; } }
                    s += __shfl_xor(s, 16); s += __shfl_xor(s, 32);
                    if (fq == 0) SSQ[(size_t)row * 12 + (pn < 2 ? pn * 4 : 8) + wc] = s; }
        } else if (pn == 3) {
#pragma unroll
            for (int ai = 0; ai < 2; ++ai)
#pragma unroll
                for (int m = 0; m < 4; ++m) { const int row = row0 + ai * HALF + m * 16;
                    *(u32x4*)(KIDX + (size_t)row * 128 + cw) = pack8(acc[ai][0][m][0], acc[ai][0][m][1]);
                    if (wc == 0 && fq < 2) { float* p = WIDX + (size_t)row * 16 + 8 * fq; *(f32x4*)p = acc[ai][1][m][0] * 0.25f; *(f32x4*)(p + 4) = acc[ai][1][m][1] * 0.25f; } }
        } else {
#pragma unroll
            for (int ai = 0; ai < 2; ++ai)
#pragma unroll
                for (int m = 0; m < 4; ++m) { const int row = row0 + ai * HALF + m * 16;
#pragma unroll
                    for (int bj = 0; bj < 2; ++bj) { f32x4 v0 = acc[ai][bj][m][0], v1 = acc[ai][bj][m][1];
#pragma unroll
                        for (int j = 0; j < 4; ++j) { v0[j] = silu_f(v0[j]); v1[j] = silu_f(v1[j]); }
                        *(u32x4*)(SG + (size_t)row * D + (pn - 4) * 256 + bj * HALF + cw) = pack8(v0, v1); } }
        }
    }
};
struct EpiDsaQ {
    static constexpr bool PERM = true;
    bf16_t* QLAT; bf16_t* QIDX; const float* SSQ;
    __device__ __forceinline__ void operator()(const f32x4 (&acc)[2][2][4][2], const Unit& u, int wr, int wc, int fr, int fq) const {
        const int row0 = u.pm * BM + wr * 64 + fr, pn = u.pn, cw = wc * 32 + 8 * fq;
#pragma unroll
        for (int ai = 0; ai < 2; ++ai)
#pragma unroll
            for (int m = 0; m < 4; ++m) { const int row = row0 + ai * HALF + m * 16;
                const f32x4 p0 = *(const f32x4*)(SSQ + (size_t)row * 12), p1 = *(const f32x4*)(SSQ + (size_t)row * 12 + 4);
                const float ss = ((p0[0] + p0[1]) + (p0[2] + p0[3])) + ((p1[0] + p1[1]) + (p1[2] + p1[3]));
                const float rs = __builtin_amdgcn_rsqf(ss * (1.0f / QR) + LN_EPS);
                bf16_t* dst = pn < 16 ? QLAT + (size_t)row * 4096 + pn * 256 : QIDX + (size_t)row * 2048 + (pn - 16) * 256;
#pragma unroll
                for (int bj = 0; bj < 2; ++bj) *(u32x4*)(dst + bj * HALF + cw) = pack8(acc[ai][bj][m][0] * rs, acc[ai][bj][m][1] * rs); }
    }
};
struct EpiUV {
    static constexpr bool PERM = true;
    const bf16_t* SG; bf16_t* GACT;
    __device__ __forceinline__ void operator()(const f32x4 (&acc)[2][2][4][2], const Unit& u, int wr, int wc, int fr, int fq) const {
        const int row0 = u.pm * BM + wr * 64 + fr, cw = u.pn * BM + wc * 32 + 8 * fq;
#pragma unroll
        for (int ai = 0; ai < 2; ++ai)
#pragma unroll
            for (int m = 0; m < 4; ++m) { const size_t off = (size_t)(row0 + ai * HALF + m * 16) * D + cw;
#pragma unroll
                for (int bj = 0; bj < 2; ++bj) { const u32x4 g = *(const u32x4*)(SG + off + bj * HALF);
                    f32x4 v0 = acc[ai][bj][m][0], v1 = acc[ai][bj][m][1];
                    v0[0] *= bf_lo(g.x); v0[1] *= bf_hi(g.x); v0[2] *= bf_lo(g.y); v0[3] *= bf_hi(g.y);
                    v1[0] *= bf_lo(g.z); v1[1] *= bf_hi(g.z); v1[2] *= bf_lo(g.w); v1[3] *= bf_hi(g.w);
                    *(u32x4*)(GACT + off + bj * HALF) = pack8(v0, v1); } }
    }
};
struct EpiZ {
    static constexpr bool PERM = false;
    const float* X; const float* GM; float* Z;
    __device__ __forceinline__ void operator()(const f32x4 (&acc)[2][2][4][2], const Unit& u, int wr, int wc, int fr, int fq) const {
        const int row0 = u.pm * BM + wr * 64 + fr, col0 = u.pn * BM + wc * 32 + 4 * fq;
        f32x4 gm[2][2];
#pragma unroll
        for (int bj = 0; bj < 2; ++bj)
#pragma unroll
            for (int n = 0; n < 2; ++n) gm[bj][n] = *(const f32x4*)(GM + col0 + bj * HALF + n * 16);
#pragma unroll
        for (int ai = 0; ai < 2; ++ai)
#pragma unroll
            for (int m = 0; m < 4; ++m) { const size_t off = (size_t)(row0 + ai * HALF + m * 16) * D + col0;
#pragma unroll
                for (int bj = 0; bj < 2; ++bj)
#pragma unroll
                    for (int n = 0; n < 2; ++n) { const f32x4 xv = *(const f32x4*)(X + off + bj * HALF + n * 16);
                        *(f32x4*)(Z + off + bj * HALF + n * 16) = xv * DN_ALPHA + gm[bj][n] * acc[ai][bj][m][n]; } }
    }
};
struct EpiMobaIn {
    static constexpr bool PERM = true;
    bf16_t* Q; bf16_t* SG; float* KMEAN;
    __device__ __forceinline__ void operator()(const f32x4 (&acc)[2][2][4][2], const Unit& u, int wr, int wc, int fr, int fq) const {
        const int row0 = u.pm * BM + wr * 64 + fr, pn = u.pn, cw = (pn & 7) * 256 + wc * 32 + 8 * fq;
        if (pn < 24) {
            bf16_t* dst = Q + (size_t)(pn >> 3) * (size_t)(16u << 20);
#pragma unroll
            for (int ai = 0; ai < 2; ++ai)
#pragma unroll
                for (int m = 0; m < 4; ++m) { const size_t off = (size_t)(row0 + ai * HALF + m * 16) * D + cw;
#pragma unroll
                    for (int bj = 0; bj < 2; ++bj) *(u32x4*)(dst + off + bj * HALF) = pack8(acc[ai][bj][m][0], acc[ai][bj][m][1]); }
            if (pn >= 8 && pn < 16) {
#pragma unroll
                for (int bj = 0; bj < 2; ++bj)
#pragma unroll
                    for (int n = 0; n < 2; ++n) {
                        float c0 = 0.f, c1 = 0.f, c2 = 0.f, c3 = 0.f;
#pragma unroll
                        for (int ai = 0; ai < 2; ++ai)
#pragma unroll
                            for (int m = 0; m < 4; ++m) { const f32x4 v = acc[ai][bj][m][n]; c0 += v[0]; c1 += v[1]; c2 += v[2]; c3 += v[3]; }
#pragma unroll
                        for (int o = 1; o < 16; o <<= 1) { c0 += __shfl_xor(c0, o); c1 += __shfl_xor(c1, o); c2 += __shfl_xor(c2, o); c3 += __shfl_xor(c3, o); }
                        if (fr == 0) { const int col = cw + bj * HALF + 4 * n; float* p = KMEAN + ((size_t)(col >> 7) * 32 + u.pm) * 128 + (col & 127);
                            atomicAdd(p, c0 * (1.0f / 256.0f)); atomicAdd(p + 1, c1 * (1.0f / 256.0f)); atomicAdd(p + 2, c2 * (1.0f / 256.0f)); atomicAdd(p + 3, c3 * (1.0f / 256.0f)); } }
            }
        } else {
#pragma unroll
            for (int ai = 0; ai < 2; ++ai)
#pragma unroll
                for (int m = 0; m < 4; ++m) { const size_t off = (size_t)(row0 + ai * HALF + m * 16) * D + cw;
#pragma unroll
                    for (int bj = 0; bj < 2; ++bj) { f32x4 v0 = acc[ai][bj][m][0], v1 = acc[ai][bj][m][1];
#pragma unroll
                        for (int j = 0; j < 4; ++j) { v0[j] = silu_f(v0[j]); v1[j] = silu_f(v1[j]); }
                        *(u32x4*)(SG + off + bj * HALF) = pack8(v0, v1); } }
        }
    }
};
}

struct Ctx {
    LAS unsigned char* lds;
    int tid, lane, wave, vcu, G, gw, NGW;
};

template <bool HAS_RS>
__device__ __forceinline__ void cvt_item(const float* src, int ld_src, int n_src0, int nvalid, int k0, bf16_t* dst, int ld_dst, int n_dst0, int kd0, int kz0,
                                         const float* rowscale, float cscale, LAS float* scr, int lane) {
    const int n = lane & 31, kh = lane >> 5;
    float v[32];
    if (nvalid > 0) {
        const int nn = n < nvalid ? n : nvalid - 1; const float mk = n < nvalid ? cscale : 0.f;
        const float* p = src + (size_t)(k0 + kh) * ld_src + n_src0 + nn;
#pragma unroll
        for (int i = 0; i < 32; ++i) v[i] = p[(size_t)(2 * i) * ld_src];
#pragma unroll
        for (int i = 0; i < 32; ++i) { float x = v[i] * mk; if (HAS_RS) x *= rowscale[k0 + 2 * i + kh]; scr[(2 * i + kh) * 33 + n] = x; }
    } else {
#pragma unroll
        for (int i = 0; i < 32; ++i) scr[(2 * i + kh) * 33 + n] = 0.f;
    }
    LDS_WAIT(); asm volatile("" ::: "memory");
    const int c = lane & 7;
#pragma unroll
    for (int j = 0; j < 4; ++j) { const int nr = (lane >> 3) + 8 * j; const LAS float* s = scr + (8 * c) * 33 + nr;
        u32x4 o; o.x = pk2(s[0 * 33], s[1 * 33]); o.y = pk2(s[2 * 33], s[3 * 33]); o.z = pk2(s[4 * 33], s[5 * 33]); o.w = pk2(s[6 * 33], s[7 * 33]);
        *(u32x4*)(dst + (size_t)(n_dst0 + nr) * ld_dst + kd0 + 8 * c) = o;
        if (kz0 >= 0) *(u32x4*)(dst + (size_t)(n_dst0 + nr) * ld_dst + kz0 + 8 * c) = (u32x4){0u, 0u, 0u, 0u}; }
    LDS_WAIT(); asm volatile("" ::: "memory");
}

__device__ __forceinline__ void phase_p0(KA a, const Ctx& c) {
    unsigned char* ws = a.ws;
    {
        const float* cvec = a.in[1]; const float* ada_w = a.in[2]; float* MODP = (float*)(ws + WS_MODP);
        for (int task = c.gw; task < 4 * 16 * 24; task += c.NGW) {
            const int nc = task % 24, kc = (task / 24) % 16, i = task / (24 * 16);
            const float* w = ada_w + ((size_t)i * 2048 + kc * 128) * 6144 + nc * 256 + c.lane * 4;
            f32x4 acc = (f32x4){0.f, 0.f, 0.f, 0.f};
#pragma unroll 16
            for (int k = 0; k < 128; ++k) { const float cv = cvec[kc * 128 + k]; const float sv = silu_f(cv); const f32x4 v = *(const f32x4*)(w + (size_t)k * 6144); acc += v * sv; }
            *(f32x4*)(MODP + (size_t)(kc * 4 + i) * 6144 + nc * 256 + c.lane * 4) = acc;
        }
    }
    {
        LAS float* scr = (LAS float*)(c.lds + c.wave * 8704);
        constexpr int I_A = 32 * 32, I_B = 64 * 32, I_C = 64 * 8, I_D = 16 * 4 * 4, I_E = 64 * 32, I_DSA = I_A + I_B + I_C + I_D + I_E;
        constexpr int I_F = 256 * 32, I_G = 64 * 32, I_MOBA = I_F + I_G, I_ALL = 2 * I_DSA + 2 * I_MOBA;
        for (int it = c.gw; it < I_ALL; it += c.NGW) {
            if (it < 2 * I_DSA) {
                const int j = it / I_DSA; int r = it % I_DSA; unsigned char* wd = ws + WS_WD0 + (size_t)j * WD_SIZE;
                if (r < I_A + I_B) {
                    const int nb = r >> 5, kb = r & 31; const float* src = a.in[6] + (size_t)j * D * DSA_IN;
                    int n_src0, nvalid; if (nb < 32) { n_src0 = nb * 32; nvalid = 912 - n_src0; nvalid = nvalid < 0 ? 0 : (nvalid > 32 ? 32 : nvalid); } else { n_src0 = 912 + (nb - 32) * 32; nvalid = 32; }
                    cvt_item<false>(src, DSA_IN, n_src0, nvalid, kb * 64, (bf16_t*)(wd + WD_WIN), D, nb * 32, kb * 64, -1, nullptr, 1.0f, scr, c.lane);
                    continue; }
                r -= I_A + I_B;
                if (r < I_C) {
                    const int nb = r >> 3, kb = r & 7; const float* src = a.in[10] + (size_t)j * QR * 2048;
                    cvt_item<true>(src, 2048, nb * 32, 32, kb * 64, (bf16_t*)(wd + WD_W2), QR, 4096 + nb * 32, kb * 64, -1, a.in[7] + j * QR, QK_SCALE, scr, c.lane);
                    continue; }
                r -= I_C;
                if (r < I_D) {
                    const int h = r >> 4, nb = (r >> 2) & 3, kb = r & 3; const float* src = a.in[12] + ((size_t)j * NH + h) * KVR * HD;
                    cvt_item<false>(src, HD, nb * 32, 32, kb * 64, (bf16_t*)(wd + WD_WUV), 512, h * HD + nb * 32, (h & 1) * 256 + kb * 64, ((h & 1) ^ 1) * 256 + kb * 64, nullptr, 1.0f, scr, c.lane);
                    continue; }
                r -= I_D;
                { const int nb = r >> 5, kb = r & 31; const float* src = a.in[13] + (size_t)j * D * D;
                  cvt_item<false>(src, D, nb * 32, 32, kb * 64, (bf16_t*)(wd + WD_WO), D, nb * 32, kb * 64, -1, nullptr, 1.0f, scr, c.lane); }
            } else {
                const int q = it - 2 * I_DSA, j = q / I_MOBA; int r = q % I_MOBA; unsigned char* wm = ws + WS_WM0 + (size_t)j * WM_SIZE;
                if (r < I_F) { const int nb = r >> 5, kb = r & 31; const float* src = a.in[14] + (size_t)j * D * MOBA_IN;
                    cvt_item<false>(src, MOBA_IN, nb * 32, 32, kb * 64, (bf16_t*)(wm + WM_WIN), D, nb * 32, kb * 64, -1, nullptr, 1.0f, scr, c.lane); }
                else { r -= I_F; const int nb = r >> 5, kb = r & 31; const float* src = a.in[15] + (size_t)j * D * D;
                    cvt_item<false>(src, D, nb * 32, 32, kb * 64, (bf16_t*)(wm + WM_WO), D, nb * 32, kb * 64, -1, nullptr, 1.0f, scr, c.lane); }
            }
        }
    }
    for (int it = c.vcu; it < 2048; it += c.G) {
        const int j = it >> 10, h = (it >> 6) & 15, k0 = (it & 63) * 8, cc = c.tid & 255, kh = c.tid >> 8;
        const float* uq = a.in[9] + (size_t)j * QR * 2048 + (size_t)(k0 + 4 * kh) * 2048 + h * HD;
        const float* uk = a.in[11] + ((size_t)j * NH + h) * HD * KVR + cc;
        float acc[4] = {0.f, 0.f, 0.f, 0.f};
#pragma unroll 8
        for (int d = 0; d < HD; ++d) { const float b = uk[d * KVR];
#pragma unroll
            for (int i = 0; i < 4; ++i) acc[i] += uq[i * 2048 + d] * b; }
        const float* gq = a.in[7] + j * QR + k0 + 4 * kh;
        u32x2 o; o.x = pk2(acc[0] * gq[0] * QK_SCALE, acc[1] * gq[1] * QK_SCALE); o.y = pk2(acc[2] * gq[2] * QK_SCALE, acc[3] * gq[3] * QK_SCALE);
        *(u32x2*)((bf16_t*)(ws + WS_WD0 + (size_t)j * WD_SIZE + WD_W2) + (size_t)(h * KVR + cc) * QR + k0 + 4 * kh) = o;
    }
#if MK_CHECK
    if (c.vcu == 0 && c.tid < DBG_WORDS) ((float*)(ws + WS_CTL + 4096))[c.tid] = 0.f;
#endif
    { float* km = (float*)(ws + WS_KMEAN); for (int i = c.vcu * 512 + c.tid; i < 2 * NH * 32 * HD; i += c.G * 512) km[i] = 0.f; }
}

__device__ __forceinline__ void phase_p1(KA a, const Ctx& c) {
    unsigned char* ws = a.ws; const float* MODP = (const float*)(ws + WS_MODP); const float* ada_b = a.in[3];
    LAS float* tab = (LAS float*)c.lds;
    for (int n = c.tid; n < 4096; n += 512) { float s = ada_b[n];
#pragma unroll
        for (int kc = 0; kc < 16; ++kc) s += MODP[(size_t)(kc * 4 + 0) * 6144 + n];
        tab[n] = n >= 2048 ? 1.0f + s : s; }
    if (c.vcu < 96 && c.tid < 256) { const int idx = c.vcu * 256 + c.tid, i = idx / 6144, n = idx % 6144; float s = ada_b[idx];
#pragma unroll
        for (int kc = 0; kc < 16; ++kc) s += MODP[(size_t)(kc * 4 + i) * 6144 + n];
        ((float*)(ws + WS_MOD))[idx] = s; }
    __syncthreads();
    const float* x = a.in[0]; bf16_t* HB = (bf16_t*)(ws + WS_HB);
    for (int t = c.gw; t < S; t += c.NGW) {
#pragma unroll
        for (int j = 0; j < 8; ++j) { const int col = 4 * c.lane + 256 * j; const f32x4 xv = *(const f32x4*)(x + (size_t)t * D + col);
            const f32x4 sh = *(const LAS f32x4*)(tab + col), sc = *(const LAS f32x4*)(tab + 2048 + col); const f32x4 hv = xv * sc + sh;
            u32x2 o; o.x = pk2(hv[0], hv[1]); o.y = pk2(hv[2], hv[3]); *(u32x2*)(HB + (size_t)t * D + col) = o; }
    }
    __syncthreads();
}

__device__ __forceinline__ void phase_ln(KA a, const Ctx& c, int layer) {
    unsigned char* ws = a.ws; const float* Z = (const float*)(ws + WS_Z); const bool last = layer == DEPTH - 1;
    float* XO = last ? a.out : (float*)(ws + WS_X1); bf16_t* HB = (bf16_t*)(ws + WS_HB);
    const float* g = a.in[4] + layer * D; const float* b = a.in[5] + layer * D;
    const float* modn = (const float*)(ws + WS_MOD) + (size_t)(last ? layer : layer + 1) * 6144;
    float chk_off = 0.f;
#if MK_CHECK
    if (last) { const float* dbg = (const float*)(ws + WS_CTL + 4096);
        if (MK_CHECK_STAGE >= 0) chk_off = dbg[MK_CHECK_STAGE < 0 ? 0 : MK_CHECK_STAGE];
        else { float best = 0.f; int bi = 0; for (int i = 1; i < DBG_WORDS; ++i) if (dbg[i] > best) { best = dbg[i]; bi = i; } chk_off = MK_CHECK_STAGE == -1 ? fminf(best, 10.f) : (float)bi; } }
#endif
    for (int t = c.gw; t < S; t += c.NGW) {
        f32x4 v[8]; float s = 0.f;
#pragma unroll
        for (int j = 0; j < 8; ++j) { v[j] = *(const f32x4*)(Z + (size_t)t * D + 4 * c.lane + 256 * j); s += (v[j][0] + v[j][1]) + (v[j][2] + v[j][3]); }
        const float mean = wave_sum(s) * (1.0f / D); float q = 0.f;
#pragma unroll
        for (int j = 0; j < 8; ++j) { v[j] = v[j] - mean; q += (v[j][0] * v[j][0] + v[j][1] * v[j][1]) + (v[j][2] * v[j][2] + v[j][3] * v[j][3]); }
        const float rstd = 1.0f / sqrtf(wave_sum(q) * (1.0f / D) + LN_EPS);
#pragma unroll
        for (int j = 0; j < 8; ++j) { const int col = 4 * c.lane + 256 * j; const f32x4 gv = *(const f32x4*)(g + col), bv = *(const f32x4*)(b + col);
            const f32x4 y = v[j] * rstd * gv + bv; *(f32x4*)(XO + (size_t)t * D + col) = y + chk_off;
            if (!last) { const f32x4 sh = *(const f32x4*)(modn + col), sc = *(const f32x4*)(modn + 2048 + col); const f32x4 hv = y * (sc + 1.0f) + sh;
                u32x2 o; o.x = pk2(hv[0], hv[1]); o.y = pk2(hv[2], hv[3]); *(u32x2*)(HB + (size_t)t * D + col) = o; } }
    }
}

__device__ __forceinline__ void dsa_ckv_norm(KA a, const Ctx& c, int j) {
    unsigned char* ws = a.ws; const float* CKV = (const float*)(ws + WU_CKV); bf16_t* CKVN = (bf16_t*)(ws + WU_CKVN); const float* SSQ = (const float*)(ws + WS_SSQ);
    const float* gkv = a.in[8] + j * KVR; const f32x4 gv = *(const f32x4*)(gkv + 4 * c.lane);
    for (int t = c.gw; t < S; t += c.NGW) {
        const f32x4 p = *(const f32x4*)(SSQ + (size_t)t * 12 + 8); const float rs = __builtin_amdgcn_rsqf(((p[0] + p[1]) + (p[2] + p[3])) * (1.0f / KVR) + LN_EPS);
        const f32x4 v = *(const f32x4*)(CKV + (size_t)t * KVR + 4 * c.lane) * rs * gv;
        u32x2 o; o.x = pk2(v[0], v[1]); o.y = pk2(v[2], v[3]); *(u32x2*)(CKVN + (size_t)t * KVR + 4 * c.lane) = o;
    }
}

__device__ __forceinline__ int idx_base(int qt) { const int a = qt >> 2, b = qt & 3; return (a + 1) * (2 * a + b); }
__device__ __forceinline__ void phase_idx_scores(KA a, const Ctx& c) {
    unsigned char* ws = a.ws; const bf16_t* QIDX = (const bf16_t*)(ws + WU_QIDX); const bf16_t* KIDX = (const bf16_t*)(ws + WU_KIDX); const float* WIDX = (const float*)(ws + WS_WIDX);
    _Float16* SC = (_Float16*)(ws + WU_SC);
    LAS float* WL = (LAS float*)(c.lds + 65536) + c.wave * 64;
    constexpr int NIT = 8320;
    const int L0 = (int)((long)NIT * c.vcu / c.G), L1 = (int)((long)NIT * (c.vcu + 1) / c.G);
    if (L0 >= L1) return;
    int qt = 0; while (idx_base(qt + 1) <= L0) ++qt;
    int kt = L0 - idx_base(qt), cur_qt = -1;
    const int lane = c.lane, r = lane & 31, hk = lane >> 5, rq = (r >> 2) & 1, head = (r & 3) + 4 * (r >> 3);
    bf16x8 qa[2][8];
    u32x4 st[4];
#define IDX_LOAD(KT_) do { _Pragma("unroll") for (int i = 0; i < 4; ++i) { const int id = c.tid + 512 * i; st[i] = *(const u32x4*)(KIDX + (size_t)(128 * (KT_) + (id >> 4)) * 128 + (id & 15) * 8); } } while (0)
#define IDX_WRITE(BUF_) do { _Pragma("unroll") for (int i = 0; i < 4; ++i) { const int id = c.tid + 512 * i, key = id >> 4, ch = id & 15; \
        *(LAS u32x4*)(c.lds + (BUF_) * 32768 + key * 256 + ((ch ^ ((key >> 2) & 15)) << 4)) = st[i]; } } while (0)
    IDX_LOAD(kt); IDX_WRITE(0);
    for (int L = L0; L < L1; ++L) {
        const int cur = (L - L0) & 1;
        if (qt != cur_qt) {
            cur_qt = qt;
#pragma unroll
            for (int rt = 0; rt < 2; ++rt) { const bf16_t* p = QIDX + (size_t)(32 * qt + 4 * c.wave + 2 * rt + rq) * 2048 + head * 128 + 8 * hk;
#pragma unroll
                for (int ks = 0; ks < 8; ++ks) qa[rt][ks] = *(const bf16x8*)(p + 16 * ks); }
            WL[lane] = WIDX[(size_t)(32 * qt + 4 * c.wave + (lane >> 4)) * 16 + (lane & 15)];
        }
        __syncthreads();
        int nqt = qt, nkt = kt + 1; if (nkt > (qt >> 2)) { nqt = qt + 1; nkt = 0; }
        const bool more = L + 1 < L1;
        if (more) IDX_LOAD(nkt);
        LAS unsigned char* KT = c.lds + cur * 32768;
        float sa0 = 0.f, sa1 = 0.f, sa2 = 0.f, sa3 = 0.f, sb0 = 0.f, sb1 = 0.f, sb2 = 0.f, sb3 = 0.f;
#pragma unroll 1
        for (int cc = 0; cc < 4; ++cc) {
            bf16x8 bfr[8];
#pragma unroll
            for (int ks = 0; ks < 8; ++ks) bfr[ks] = *(const LAS bf16x8*)(KT + (4 * r + cc) * 256 + (((ks * 2 + hk) ^ (r & 15)) << 4));
            f32x16 acc0 = {}, acc1 = {};
#pragma unroll
            for (int ks = 0; ks < 8; ++ks) { acc0 = __builtin_amdgcn_mfma_f32_32x32x16_bf16(qa[0][ks], bfr[ks], acc0, 0, 0, 0);
                acc1 = __builtin_amdgcn_mfma_f32_32x32x16_bf16(qa[1][ks], bfr[ks], acc1, 0, 0, 0); }
            float s0 = 0.f, s1 = 0.f;
            { const LAS f32x4* wp = (const LAS f32x4*)(WL + hk * 16);
#pragma unroll
              for (int q4 = 0; q4 < 4; ++q4) { const f32x4 w = wp[q4];
#pragma unroll
                  for (int e = 0; e < 4; ++e) s0 += w[e] * fmaxf(acc0[4 * q4 + e], 0.f); } }
            { const LAS f32x4* wp = (const LAS f32x4*)(WL + (2 + hk) * 16);
#pragma unroll
              for (int q4 = 0; q4 < 4; ++q4) { const f32x4 w = wp[q4];
#pragma unroll
                  for (int e = 0; e < 4; ++e) s1 += w[e] * fmaxf(acc1[4 * q4 + e], 0.f); } }
            sa0 = cc == 0 ? s0 : sa0; sa1 = cc == 1 ? s0 : sa1; sa2 = cc == 2 ? s0 : sa2; sa3 = cc == 3 ? s0 : sa3;
            sb0 = cc == 0 ? s1 : sb0; sb1 = cc == 1 ? s1 : sb1; sb2 = cc == 2 ? s1 : sb2; sb3 = cc == 3 ? s1 : sb3;
        }
        { typedef _Float16 h4 __attribute__((ext_vector_type(4)));
          h4 hv; hv[0] = (_Float16)sa0; hv[1] = (_Float16)sa1; hv[2] = (_Float16)sa2; hv[3] = (_Float16)sa3;
          *(h4*)(SC + (size_t)(32 * qt + 4 * c.wave + hk) * S + 128 * kt + 4 * r) = hv;
          hv[0] = (_Float16)sb0; hv[1] = (_Float16)sb1; hv[2] = (_Float16)sb2; hv[3] = (_Float16)sb3;
          *(h4*)(SC + (size_t)(32 * qt + 4 * c.wave + 2 + hk) * S + 128 * kt + 4 * r) = hv; }
        if (more) IDX_WRITE(cur ^ 1);
        qt = nqt; kt = nkt;
    }
#undef IDX_LOAD
#undef IDX_WRITE
    __syncthreads();
}

__device__ __forceinline__ unsigned f16key(unsigned h) { return (h & 0x8000u) ? (~h & 0xffffu) : (h | 0x8000u); }
__device__ __forceinline__ void hist_find(LAS unsigned* hist, int need, int lane, int& bsel, int& above) {
    LDS_WAIT();
    const u32x4 hv = *(const LAS u32x4*)(hist + 4 * (63 - lane));
    const int c0 = hv.w, c1 = hv.z, c2 = hv.y, c3 = hv.x, tot = c0 + c1 + c2 + c3;
    int inc = tot;
#pragma unroll
    for (int o = 1; o < 64; o <<= 1) { const int t = __shfl_up(inc, o); if (lane >= o) inc += t; }
    const int ex = inc - tot;
    const bool here = ex < need && inc >= need;
    int b = 0, ab = 0;
    if (here) { int cum = ex; if (cum + c0 >= need) { b = 255 - 4 * lane; ab = cum; } else { cum += c0; if (cum + c1 >= need) { b = 254 - 4 * lane; ab = cum; } else { cum += c1; if (cum + c2 >= need) { b = 253 - 4 * lane; ab = cum; } else { cum += c2; b = 252 - 4 * lane; ab = cum; } } } }
    const unsigned long long m = __ballot(here); const int src = m ? __builtin_ctzll(m) : 0;
    bsel = __shfl(b, src); above = __shfl(ab, src);
}
typedef short s16x4 __attribute__((ext_vector_type(4)));
__device__ __forceinline__ f32x4 mfma16(bf16x8 a_, bf16x8 b_, f32x4 c_) { return __builtin_amdgcn_mfma_f32_16x16x32_bf16(a_, b_, c_, 0, 0, 0); }
__device__ __forceinline__ void phase_dsa_attn(KA a, const Ctx& c) {
    unsigned char* ws = a.ws; const unsigned short* SC = (const unsigned short*)(ws + WU_SC); const bf16_t* CKVN = (const bf16_t*)(ws + WU_CKVN);
    const bf16_t* QLAT = (const bf16_t*)(ws + WU_QLAT); bf16_t* OLAT = (bf16_t*)(ws + WU_OLAT);
    LAS unsigned char* wl = c.lds + c.wave * 18432;
    LAS unsigned* hist = (LAS unsigned*)wl; LAS unsigned short* sel = (LAS unsigned short*)(wl + 1024); LAS unsigned char* kvl = wl + 2048;
    const int lane = c.lane, n16 = lane & 15, kq = lane >> 4;
    for (int t = c.gw; t < S; t += c.NGW) {
        const int nvalid = t + 1; int kk;
        if (nvalid <= 256) {
            kk = nvalid;
#pragma unroll
            for (int i = 0; i < 4; ++i) { const int k = lane + 64 * i; sel[k] = (unsigned short)(k < nvalid ? k : 0); }
        } else {
            kk = 256;
            const int lastc = t >> 3, nj = (t >> 9) + 1;
            *(LAS u32x4*)(hist + 4 * lane) = (u32x4){0u, 0u, 0u, 0u}; LDS_WAIT();
#pragma unroll 2
            for (int j = 0; j < nj; ++j) { const int ci = j * 64 + lane, cl = ci < lastc ? ci : lastc, s0 = ci * 8;
                u32x4 w = *(const u32x4*)(SC + (size_t)t * S + (size_t)cl * 8);
#pragma unroll
                for (int e = 0; e < 4; ++e) { unsigned k0 = f16key(w[e] & 0xffffu), k1 = f16key(w[e] >> 16);
                    k0 = (s0 + 2 * e > t) ? 0u : k0; k1 = (s0 + 2 * e + 1 > t) ? 0u : k1; w[e] = k0 | (k1 << 16);
                    __hip_atomic_fetch_add(hist + (k0 >> 8), 1u, __ATOMIC_RELAXED, __HIP_MEMORY_SCOPE_WORKGROUP);
                    __hip_atomic_fetch_add(hist + (k1 >> 8), 1u, __ATOMIC_RELAXED, __HIP_MEMORY_SCOPE_WORKGROUP); }
                *(LAS u32x4*)(kvl + ci * 16) = w; }
            int b1, above1; hist_find(hist, 256, lane, b1, above1);
            *(LAS u32x4*)(hist + 4 * lane) = (u32x4){0u, 0u, 0u, 0u}; LDS_WAIT();
#pragma unroll 2
            for (int j = 0; j < nj; ++j) { const u32x4 w = *(const LAS u32x4*)(kvl + (j * 64 + lane) * 16);
#pragma unroll
                for (int e = 0; e < 4; ++e) {
                    if ((int)((w[e] >> 8) & 0xff) == b1) __hip_atomic_fetch_add(hist + (w[e] & 0xff), 1u, __ATOMIC_RELAXED, __HIP_MEMORY_SCOPE_WORKGROUP);
                    if ((int)(w[e] >> 24) == b1) __hip_atomic_fetch_add(hist + ((w[e] >> 16) & 0xff), 1u, __ATOMIC_RELAXED, __HIP_MEMORY_SCOPE_WORKGROUP); } }
            int b2, above2; hist_find(hist, 256 - above1, lane, b2, above2);
            const unsigned T = ((unsigned)b1 << 8) | (unsigned)b2; const int need_eq = 256 - above1 - above2;
            int cnt = 0, eqc = 0;
#pragma unroll 1
            for (int j = 0; j < nj; ++j) { const u32x4 w = *(const LAS u32x4*)(kvl + (j * 64 + lane) * 16);
#pragma unroll
                for (int e = 0; e < 8; ++e) { const unsigned k = (w[e >> 1] >> ((e & 1) * 16)) & 0xffffu;
                    const bool gt = k > T, eq = k == T;
                    const unsigned long long be = __ballot(eq);
                    const int eqrank = eqc + __builtin_amdgcn_mbcnt_hi((unsigned)(be >> 32), __builtin_amdgcn_mbcnt_lo((unsigned)be, 0));
                    const bool take = gt || (eq && eqrank < need_eq);
                    const unsigned long long bt = __ballot(take);
                    const int pos = cnt + __builtin_amdgcn_mbcnt_hi((unsigned)(bt >> 32), __builtin_amdgcn_mbcnt_lo((unsigned)bt, 0));
                    if (take) sel[pos] = (unsigned short)((j * 64 + lane) * 8 + e);
                    cnt += __builtin_popcountll(bt); eqc += __builtin_popcountll(be); } }
        }
        LDS_WAIT(); __builtin_amdgcn_sched_barrier(0);
        bf16x8 qf[8];
        { const bf16_t* qrow = QLAT + (size_t)t * 4096 + n16 * KVR + 8 * kq;
#pragma unroll
          for (int ks = 0; ks < 8; ++ks) qf[ks] = *(const bf16x8*)(qrow + 32 * ks); }
        f32x4 oacc[16];
#pragma unroll
        for (int ct = 0; ct < 16; ++ct) oacc[ct] = (f32x4){0.f, 0.f, 0.f, 0.f};
        float m_run = -1.0e30f, l_run = 0.f;
        const float slope = __builtin_amdgcn_exp2f(-0.5f * (float)(n16 + 1));
        const int nch = (kk + 31) >> 5;
        const int trq = n16 >> 2, trp = n16 & 3, trrow = 4 * kq + trq;
        for (int ch = 0; ch < nch; ++ch) {
#pragma unroll
            for (int hf = 0; hf < 2; ++hf) {
                u32x4 stg[8];
#pragma unroll
                for (int i = 0; i < 8; ++i) { const int row = 16 * hf + 2 * i + (lane >> 5), kidx = ch * 32 + row; const int sk = sel[kidx < kk ? kidx : 0];
                    stg[i] = *(const u32x4*)(CKVN + (size_t)sk * KVR + (lane & 31) * 8); }
#pragma unroll
                for (int i = 0; i < 8; ++i) { const int row = 16 * hf + 2 * i + (lane >> 5), cch = lane & 31;
                    *(LAS u32x4*)(kvl + row * 512 + (((cch & 16) | ((cch & 15) ^ (row & 15))) << 4)) = stg[i]; }
                __builtin_amdgcn_sched_barrier(0);
            }
            LDS_WAIT();
            f32x4 s0 = (f32x4){0.f, 0.f, 0.f, 0.f}, s1 = (f32x4){0.f, 0.f, 0.f, 0.f};
#pragma unroll
            for (int ks = 0; ks < 8; ++ks) { const int chunk = 4 * ks + kq, sw = ((chunk & 16) | ((chunk & 15) ^ n16)) << 4;
                const bf16x8 a0 = *(const LAS bf16x8*)(kvl + n16 * 512 + sw), a1 = *(const LAS bf16x8*)(kvl + (16 + n16) * 512 + sw);
                s0 = mfma16(a0, qf[ks], s0); s1 = mfma16(a1, qf[ks], s1); }
            float mx = -1.0e30f;
#pragma unroll
            for (int r = 0; r < 4; ++r) { const int k0 = ch * 32 + 4 * kq + r, k1 = k0 + 16;
                const int sk0 = sel[k0 < kk ? k0 : 0], sk1 = sel[k1 < kk ? k1 : 0];
                s0[r] = k0 < kk ? s0[r] - slope * (float)(t - sk0) : -1.0e30f; s1[r] = k1 < kk ? s1[r] - slope * (float)(t - sk1) : -1.0e30f;
                mx = fmaxf(mx, fmaxf(s0[r], s1[r])); }
            mx = fmaxf(mx, __shfl_xor(mx, 16)); mx = fmaxf(mx, __shfl_xor(mx, 32));
            const float m_new = fmaxf(m_run, mx), alpha = __builtin_amdgcn_exp2f((m_run - m_new) * LOG2E); m_run = m_new;
            float ps = 0.f;
#pragma unroll
            for (int r = 0; r < 4; ++r) { s0[r] = __builtin_amdgcn_exp2f((s0[r] - m_new) * LOG2E); s1[r] = __builtin_amdgcn_exp2f((s1[r] - m_new) * LOG2E); ps += s0[r] + s1[r]; }
            l_run = l_run * alpha + ps;
#pragma unroll
            for (int ct = 0; ct < 16; ++ct) oacc[ct] *= alpha;
            u32x4 pw; pw.x = cvt_pk_bf16(s0[0], s0[1]); pw.y = cvt_pk_bf16(s0[2], s0[3]); pw.z = cvt_pk_bf16(s1[0], s1[1]); pw.w = cvt_pk_bf16(s1[2], s1[3]);
            const bf16x8 pb = __builtin_bit_cast(bf16x8, pw);
#pragma unroll
            for (int ct = 0; ct < 16; ++ct) { const int chunk = 2 * ct + (trp >> 1), sw = (((chunk & 16) | ((chunk & 15) ^ (trrow & 15))) << 4) + 8 * (trp & 1);
                const s16x4 t0 = __builtin_amdgcn_ds_read_tr16_b64_v4i16((LAS s16x4*)(kvl + trrow * 512 + sw));
                const s16x4 t1 = __builtin_amdgcn_ds_read_tr16_b64_v4i16((LAS s16x4*)(kvl + (16 + trrow) * 512 + sw));
                const bf16x8 a2 = (bf16x8){t0[0], t0[1], t0[2], t0[3], t1[0], t1[1], t1[2], t1[3]};
                oacc[ct] = mfma16(a2, pb, oacc[ct]); }
            LDS_WAIT();
        }
        float lt = l_run; lt += __shfl_xor(lt, 16); lt += __shfl_xor(lt, 32);
        const float inv = 1.0f / lt;
#pragma unroll
        for (int ct = 0; ct < 16; ++ct) { const f32x4 o = oacc[ct] * inv; u32x2 w; w.x = cvt_pk_bf16(o[0], o[1]); w.y = cvt_pk_bf16(o[2], o[3]);
            *(u32x2*)(OLAT + (size_t)t * 4096 + n16 * KVR + 16 * ct + 4 * kq) = w; }
    }
}

__device__ __forceinline__ void phase_moba_attn_v1(KA a, const Ctx& c, int j) {
    unsigned char* ws = a.ws; const bf16_t* Q = (const bf16_t*)(ws + WU_Q); const bf16_t* Kb = (const bf16_t*)(ws + WU_K); const bf16_t* V = (const bf16_t*)(ws + WU_V);
    const bf16_t* SG = (const bf16_t*)(ws + WS_SG); bf16_t* GACT = (bf16_t*)(ws + WS_GACT); const float* KMEAN = (const float*)(ws + WS_KMEAN) + (size_t)j * NH * 32 * HD;
    LAS float* pl = (LAS float*)(c.lds + c.wave * 4608);
    const int lane = c.lane;
    for (int pr = c.gw; pr < S * NH; pr += c.NGW) {
        const int t = pr >> 4, h = pr & 15, own = t >> 8;
        unsigned qw[64];
        { const u32x4* qp4 = (const u32x4*)(Q + (size_t)t * D + h * HD);
#pragma unroll
          for (int i = 0; i < 16; ++i) { const u32x4 v = qp4[i]; qw[4 * i] = v.x; qw[4 * i + 1] = v.y; qw[4 * i + 2] = v.z; qw[4 * i + 3] = v.w; } }
        float g = -3.0e38f;
        if (lane < own && lane < 32) { const float* km = KMEAN + ((size_t)h * 32 + lane) * HD; float s = 0.f;
#pragma unroll
            for (int i = 0; i < 32; ++i) { const f32x4 kv = *(const f32x4*)(km + 4 * i); s += bf_lo(qw[2 * i]) * kv[0] + bf_hi(qw[2 * i]) * kv[1] + bf_lo(qw[2 * i + 1]) * kv[2] + bf_hi(qw[2 * i + 1]) * kv[3]; }
            g = s; }
        int blk[4]; bool bval[4];
#pragma unroll
        for (int r = 0; r < 3; ++r) { const float m = wave_max(g); const unsigned long long bm = __ballot(g == m && g > -1.0e38f);
            if (bm) { const int n = __builtin_ctzll(bm); blk[r] = n; bval[r] = true; if (lane == n) g = -3.0e38f; } else { blk[r] = 0; bval[r] = false; } }
        blk[3] = own; bval[3] = true;
        const float slope = __builtin_amdgcn_exp2f(-0.5f * (float)(h + 1));
        float sc[4][4]; float mx = -3.0e38f;
#pragma unroll
        for (int b = 0; b < 4; ++b)
#pragma unroll
            for (int i = 0; i < 4; ++i) {
                const int pos = blk[b] * 256 + i * 64 + lane; float s = -3.0e38f;
                if (bval[b]) { const u32x4* kp = (const u32x4*)(Kb + (size_t)pos * D + h * HD); float d = 0.f;
#pragma unroll
                    for (int q4 = 0; q4 < 16; ++q4) { const u32x4 kv = kp[q4]; d = dot2bf(qw[4 * q4], kv.x, d); d = dot2bf(qw[4 * q4 + 1], kv.y, d); d = dot2bf(qw[4 * q4 + 2], kv.z, d); d = dot2bf(qw[4 * q4 + 3], kv.w, d); }
                    if (pos <= t) s = d * QK_SCALE - slope * (float)(t - pos); }
                sc[b][i] = s; mx = fmaxf(mx, s); }
        mx = wave_max(mx);
        float sum = 0.f;
#pragma unroll
        for (int b = 0; b < 4; ++b)
#pragma unroll
            for (int i = 0; i < 4; ++i) { const float e = sc[b][i] > -1.0e38f ? __builtin_amdgcn_exp2f((sc[b][i] - mx) * LOG2E) : 0.f; sc[b][i] = e; sum += e; }
        const float inv = 1.0f / wave_sum(sum);
#pragma unroll
        for (int b = 0; b < 4; ++b)
#pragma unroll
            for (int i = 0; i < 4; ++i) pl[b * 256 + i * 64 + lane] = sc[b][i] * inv;
        LDS_WAIT();
        const int kg = lane >> 4, dq = lane & 15;
        float o[8];
#pragma unroll
        for (int e = 0; e < 8; ++e) o[e] = 0.f;
#pragma unroll
        for (int b = 0; b < 4; ++b) if (bval[b]) {
            const bf16_t* vb = V + (size_t)(blk[b] * 256) * D + h * HD + 8 * dq;
#pragma unroll 8
            for (int k4 = 0; k4 < 64; ++k4) { const int k = 4 * k4 + kg; const float p = pl[b * 256 + k]; const u32x4 vv = *(const u32x4*)(vb + (size_t)k * D);
                o[0] += p * bf_lo(vv.x); o[1] += p * bf_hi(vv.x); o[2] += p * bf_lo(vv.y); o[3] += p * bf_hi(vv.y);
                o[4] += p * bf_lo(vv.z); o[5] += p * bf_hi(vv.z); o[6] += p * bf_lo(vv.w); o[7] += p * bf_hi(vv.w); } }
#pragma unroll
        for (int e = 0; e < 8; ++e) { o[e] += __shfl_xor(o[e], 16); o[e] += __shfl_xor(o[e], 32); }
        if (kg == 0) { const size_t off = (size_t)t * D + h * HD + 8 * dq; const u32x4 gv = *(const u32x4*)(SG + off);
            u32x4 w; w.x = pk2(o[0] * bf_lo(gv.x), o[1] * bf_hi(gv.x)); w.y = pk2(o[2] * bf_lo(gv.y), o[3] * bf_hi(gv.y));
            w.z = pk2(o[4] * bf_lo(gv.z), o[5] * bf_hi(gv.z)); w.w = pk2(o[6] * bf_lo(gv.w), o[7] * bf_hi(gv.w));
            *(u32x4*)(GACT + off) = w; }
        LDS_WAIT();
    }
}


__device__ __forceinline__ float bfu(bf16_t v) { return __builtin_bit_cast(float, (unsigned)v << 16); }
struct ChkAcc { LAS float* ss; LAS unsigned* mx; LAS unsigned* cnt; };
__device__ __forceinline__ void chk_add(const ChkAcc& A, float naive, float mine) {
    atomicAdd((float*)A.ss, naive * naive); atomicMax((unsigned*)A.mx, __builtin_bit_cast(unsigned, fabsf(naive - mine))); atomicAdd((unsigned*)A.cnt, 1u);
}
__device__ __forceinline__ void chk_begin(const ChkAcc& A, int tid) { __syncthreads(); if (tid == 0) { *A.ss = 0.f; *A.mx = 0u; *A.cnt = 0u; } __syncthreads(); }
__device__ __forceinline__ void chk_end(const ChkAcc& A, int tid, float* dbg, int stage) {
    __syncthreads();
    if (tid == 0) { const float rms = sqrtf(*A.ss / fmaxf((float)*A.cnt, 1.f)) + 1e-20f; const float e = __builtin_bit_cast(float, *A.mx) / rms;
        atomicMax((unsigned*)(dbg + stage), __builtin_bit_cast(unsigned, e)); }
    __syncthreads();
}
__device__ __forceinline__ unsigned f16key_d(unsigned h) { return (h & 0x8000u) ? (~h & 0xffffu) : (h | 0x8000u); }

__device__ __forceinline__ void check_dsa(KA a, unsigned char* ws, LAS unsigned char* lds, int tid, int layer) {
    const int j = layer >> 1; float* dbg = (float*)(ws + WS_CTL + 4096) + layer * 16;
    ChkAcc A{(LAS float*)(lds + 0), (LAS unsigned*)(lds + 4), (LAS unsigned*)(lds + 8)};
    LAS float* buf = (LAS float*)(lds + 1024);
    LAS unsigned short* keys = (LAS unsigned short*)(lds + 1024 + 32768);
    LAS int* slist = (LAS int*)(lds + 1024 + 32768 + 16384);
    LAS float* lgt = (LAS float*)(lds + 1024 + 32768 + 16384 + 2048);
    const bf16_t* HB = (const bf16_t*)(ws + WS_HB); const bf16_t* CQ = (const bf16_t*)(ws + WU_CQ); const float* CKV = (const float*)(ws + WU_CKV);
    const bf16_t* CKVN = (const bf16_t*)(ws + WU_CKVN); const bf16_t* KIDX = (const bf16_t*)(ws + WU_KIDX); const float* WIDX = (const float*)(ws + WS_WIDX);
    const bf16_t* SG = (const bf16_t*)(ws + WS_SG); const bf16_t* QLAT = (const bf16_t*)(ws + WU_QLAT); const bf16_t* QIDX = (const bf16_t*)(ws + WU_QIDX);
    const unsigned short* SC = (const unsigned short*)(ws + WU_SC); const bf16_t* OLAT = (const bf16_t*)(ws + WU_OLAT); const bf16_t* GACT = (const bf16_t*)(ws + WS_GACT);
    const float* Z = (const float*)(ws + WS_Z); const float* MOD = (const float*)(ws + WS_MOD);
    const float* w_in = a.in[6] + (size_t)j * D * DSA_IN; const float* g_q = a.in[7] + j * QR; const float* g_kv = a.in[8] + j * KVR;
    const float* w_uq = a.in[9] + (size_t)j * QR * 2048; const float* w_qi = a.in[10] + (size_t)j * QR * 2048; const float* w_uk = a.in[11] + (size_t)j * NH * HD * KVR;
    const float* w_uv = a.in[12] + (size_t)j * NH * KVR * HD; const float* w_o = a.in[13] + (size_t)j * D * D;
    const float* X = layer == 0 ? a.in[0] : (const float*)(ws + WS_X1);
    for (int ti = 0; ti < 32; ++ti) {
        const int t = (int)(blockIdx.x + 256u * ti);
        chk_begin(A, tid);
        for (int n = tid; n < DSA_IN; n += 512) { float s = 0.f; for (int k = 0; k < D; ++k) s += bfu(HB[(size_t)t * D + k]) * w_in[(size_t)k * DSA_IN + n];
            float mine;
            if (n < 512) mine = bfu(CQ[(size_t)t * QR + n]); else if (n < 768) mine = CKV[(size_t)t * KVR + n - 512]; else if (n < 896) mine = bfu(KIDX[(size_t)t * 128 + n - 768]);
            else if (n < 912) { mine = WIDX[(size_t)t * 16 + n - 896]; s *= 0.25f; } else { mine = bfu(SG[(size_t)t * D + n - 912]); s = s / (1.f + expf(-s)); }
            chk_add(A, s, mine); }
        chk_end(A, tid, dbg, 1);
        chk_begin(A, tid);
        { float ss = 0.f; for (int k = 0; k < KVR; ++k) { const float v = CKV[(size_t)t * KVR + k]; ss += v * v; } const float rs = 1.f / sqrtf(ss / KVR + LN_EPS);
          for (int n = tid; n < KVR; n += 512) chk_add(A, CKV[(size_t)t * KVR + n] * rs * g_kv[n], bfu(CKVN[(size_t)t * KVR + n])); }
        chk_end(A, tid, dbg, 1);
        { float ss = 0.f; for (int k = 0; k < QR; ++k) { const float v = bfu(CQ[(size_t)t * QR + k]); ss += v * v; } const float rs = 1.f / sqrtf(ss / QR + LN_EPS);
          __syncthreads();
          for (int k = tid; k < QR; k += 512) buf[k] = bfu(CQ[(size_t)t * QR + k]) * rs * g_q[k];
          __syncthreads();
          for (int n = tid; n < 2048; n += 512) { float s = 0.f; for (int k = 0; k < QR; ++k) s += buf[k] * w_uq[(size_t)k * 2048 + n]; buf[1024 + n] = s; }
          chk_begin(A, tid);
          for (int n = tid; n < 4096; n += 512) { const int h = n >> 8, cc = n & 255; float s = 0.f; for (int d = 0; d < HD; ++d) s += buf[1024 + h * HD + d] * w_uk[((size_t)h * HD + d) * KVR + cc];
              chk_add(A, s * QK_SCALE, bfu(QLAT[(size_t)t * 4096 + n])); }
          chk_end(A, tid, dbg, 2);
          chk_begin(A, tid);
          for (int n = tid; n < 2048; n += 512) { float s = 0.f; for (int k = 0; k < QR; ++k) s += buf[k] * w_qi[(size_t)k * 2048 + n]; chk_add(A, s * QK_SCALE, bfu(QIDX[(size_t)t * 2048 + n])); }
          chk_end(A, tid, dbg, 2); }
        chk_begin(A, tid);
        for (int sidx = tid; sidx <= t; sidx += 512) { float sc = 0.f;
            for (int h = 0; h < 16; ++h) { float l = 0.f; for (int d = 0; d < 128; ++d) l += bfu(QIDX[(size_t)t * 2048 + h * 128 + d]) * bfu(KIDX[(size_t)sidx * 128 + d]); sc += WIDX[(size_t)t * 16 + h] * fmaxf(l, 0.f); }
            const unsigned short hb = SC[(size_t)t * S + sidx]; _Float16 hv = __builtin_bit_cast(_Float16, hb); chk_add(A, sc, (float)hv); }
        chk_end(A, tid, dbg, 3);
        __syncthreads();
        for (int sidx = tid; sidx < S; sidx += 512) keys[sidx] = sidx <= t ? (unsigned short)f16key_d(SC[(size_t)t * S + sidx]) : (unsigned short)0;
        if (tid == 0) slist[256] = 0;
        __syncthreads();
        const int kk = t + 1 < 256 ? t + 1 : 256;
        for (int sidx = tid; sidx <= t; sidx += 512) {
            bool selq;
            if (t + 1 <= 256) selq = true;
            else { const unsigned k0 = keys[sidx]; const int o0 = (sidx >> 9) * 512 + (sidx & 7) * 64 + ((sidx >> 3) & 63); int rank = 0;
                for (int s2 = 0; s2 <= t; ++s2) { const unsigned k2 = keys[s2]; const int o2 = (s2 >> 9) * 512 + (s2 & 7) * 64 + ((s2 >> 3) & 63); rank += (k2 > k0 || (k2 == k0 && o2 < o0)) ? 1 : 0; }
                selq = rank < 256; }
            if (selq) { const int p = atomicAdd((int*)&slist[256], 1); if (p < 256) slist[p] = sidx; } }
        __syncthreads();
        for (int idx = tid; idx < 16 * 256; idx += 512) { const int h = idx >> 8, k = idx & 255; float l = -1e30f;
            if (k < kk) { const int sk = slist[k]; float s = 0.f; for (int cc = 0; cc < KVR; ++cc) s += bfu(QLAT[(size_t)t * 4096 + h * KVR + cc]) * bfu(CKVN[(size_t)sk * KVR + cc]);
                l = s - exp2f(-0.5f * (float)(h + 1)) * (float)(t - sk); }
            lgt[idx] = l; }
        __syncthreads();
        if (tid < 16) { float m = -1e30f; for (int k = 0; k < 256; ++k) m = fmaxf(m, lgt[tid * 256 + k]); float sum = 0.f; for (int k = 0; k < 256; ++k) { const float e = lgt[tid * 256 + k] > -1e29f ? expf(lgt[tid * 256 + k] - m) : 0.f; lgt[tid * 256 + k] = e; sum += e; }
            for (int k = 0; k < 256; ++k) lgt[tid * 256 + k] /= sum; }
        chk_begin(A, tid);
        for (int n = tid; n < 4096; n += 512) { const int h = n >> 8, cc = n & 255; float s = 0.f; for (int k = 0; k < kk; ++k) s += lgt[h * 256 + k] * bfu(CKVN[(size_t)slist[k] * KVR + cc]);
            chk_add(A, s, bfu(OLAT[(size_t)t * 4096 + n])); }
        chk_end(A, tid, dbg, 5);
        chk_begin(A, tid);
        for (int n = tid; n < D; n += 512) { const int h = n >> 7, d = n & 127; float s = 0.f; for (int cc = 0; cc < KVR; ++cc) s += bfu(OLAT[(size_t)t * 4096 + h * KVR + cc]) * w_uv[((size_t)h * KVR + cc) * HD + d];
            chk_add(A, s * bfu(SG[(size_t)t * D + n]), bfu(GACT[(size_t)t * D + n])); }
        chk_end(A, tid, dbg, 6);
        chk_begin(A, tid);
        for (int n = tid; n < D; n += 512) { float s = 0.f; for (int k = 0; k < D; ++k) s += bfu(GACT[(size_t)t * D + k]) * w_o[(size_t)k * D + n];
            chk_add(A, DN_ALPHA * X[(size_t)t * D + n] + MOD[(size_t)layer * 6144 + 4096 + n] * s, Z[(size_t)t * D + n]); }
        chk_end(A, tid, dbg, 7);
    }
}
__device__ __forceinline__ void check_moba(KA a, unsigned char* ws, LAS unsigned char* lds, int tid, int layer) {
    const int j = layer >> 1; float* dbg = (float*)(ws + WS_CTL + 4096) + layer * 16;
    ChkAcc A{(LAS float*)(lds + 0), (LAS unsigned*)(lds + 4), (LAS unsigned*)(lds + 8)};
    LAS float* pbuf = (LAS float*)(lds + 1024);
    LAS int* blks = (LAS int*)(lds + 1024 + 65536);
    const bf16_t* HB = (const bf16_t*)(ws + WS_HB); const bf16_t* Q = (const bf16_t*)(ws + WU_Q); const bf16_t* Kb = (const bf16_t*)(ws + WU_K); const bf16_t* V = (const bf16_t*)(ws + WU_V);
    const bf16_t* SG = (const bf16_t*)(ws + WS_SG); const bf16_t* GACT = (const bf16_t*)(ws + WS_GACT); const float* KMEAN = (const float*)(ws + WS_KMEAN) + (size_t)j * NH * 32 * HD;
    const float* Z = (const float*)(ws + WS_Z); const float* MOD = (const float*)(ws + WS_MOD); const float* X = (const float*)(ws + WS_X1);
    const float* w_in = a.in[14] + (size_t)j * D * MOBA_IN; const float* w_o = a.in[15] + (size_t)j * D * D;
    chk_begin(A, tid);
    for (int idx = tid; idx < 4 * 128; idx += 512) { const int which = idx >> 7, d = idx & 127; const int h = (which * 5 + 1 + blockIdx.x) & 15, n = (which * 11 + 2 + blockIdx.x * 7) & 31; float s = 0.f;
        for (int r = 0; r < 256; ++r) s += bfu(Kb[(size_t)(n * 256 + r) * D + h * HD + d]); chk_add(A, s / 256.f, KMEAN[((size_t)h * 32 + n) * HD + d]); }
    chk_end(A, tid, dbg, 10);
    for (int ti = 0; ti < 32; ++ti) {
        const int t = (int)(blockIdx.x + 256u * ti), own = t >> 8;
        chk_begin(A, tid);
        for (int n = tid; n < MOBA_IN; n += 512) { float s = 0.f; for (int k = 0; k < D; ++k) s += bfu(HB[(size_t)t * D + k]) * w_in[(size_t)k * MOBA_IN + n];
            float mine; const int seg = n >> 11, cn = n & 2047;
            if (seg == 0) mine = bfu(Q[(size_t)t * D + cn]); else if (seg == 1) mine = bfu(Kb[(size_t)t * D + cn]); else if (seg == 2) mine = bfu(V[(size_t)t * D + cn]); else { mine = bfu(SG[(size_t)t * D + cn]); s = s / (1.f + expf(-s)); }
            chk_add(A, s, mine); }
        chk_end(A, tid, dbg, 9);
        __syncthreads();
        { LAS float* gg = pbuf;
          for (int idx = tid; idx < 16 * 32; idx += 512) { const int h = idx >> 5, n = idx & 31; float s = -3e38f;
              if (n < own) { s = 0.f; for (int d = 0; d < HD; ++d) s += bfu(Q[(size_t)t * D + h * HD + d]) * KMEAN[((size_t)h * 32 + n) * HD + d]; } gg[idx] = s; }
          __syncthreads();
          if (tid < 16) { const int h = tid;
              for (int r = 0; r < 3; ++r) { int best = -1; float bv = -1e38f; for (int n = 0; n < 32; ++n) if (gg[h * 32 + n] > bv) { bv = gg[h * 32 + n]; best = n; } blks[h * 4 + r] = best; if (best >= 0) gg[h * 32 + best] = -3e38f; }
              blks[h * 4 + 3] = own; } }
        __syncthreads();
        for (int idx = tid; idx < 16 * 1024; idx += 512) { const int h = idx >> 10, b = (idx >> 8) & 3, k = idx & 255; const int blk = blks[h * 4 + b]; float l = -1e30f;
            if (blk >= 0) { const int pos = blk * 256 + k; if (pos <= t) { float s = 0.f; for (int d = 0; d < HD; ++d) s += bfu(Q[(size_t)t * D + h * HD + d]) * bfu(Kb[(size_t)pos * D + h * HD + d]);
                l = s * QK_SCALE - exp2f(-0.5f * (float)(h + 1)) * (float)(t - pos); } }
            pbuf[idx] = l; }
        __syncthreads();
        if (tid < 16) { float m = -1e30f; for (int k = 0; k < 1024; ++k) m = fmaxf(m, pbuf[tid * 1024 + k]); float sum = 0.f;
            for (int k = 0; k < 1024; ++k) { const float e = pbuf[tid * 1024 + k] > -1e29f ? expf(pbuf[tid * 1024 + k] - m) : 0.f; pbuf[tid * 1024 + k] = e; sum += e; }
            for (int k = 0; k < 1024; ++k) pbuf[tid * 1024 + k] /= sum; }
        chk_begin(A, tid);
        for (int n = tid; n < D; n += 512) { const int h = n >> 7, d = n & 127; float s = 0.f;
            for (int b = 0; b < 4; ++b) { const int blk = blks[h * 4 + b]; if (blk < 0) continue; for (int k = 0; k < 256; ++k) s += pbuf[h * 1024 + b * 256 + k] * bfu(V[(size_t)(blk * 256 + k) * D + n]); }
            chk_add(A, s * bfu(SG[(size_t)t * D + n]), bfu(GACT[(size_t)t * D + n])); (void)d; }
        chk_end(A, tid, dbg, 11);
        chk_begin(A, tid);
        for (int n = tid; n < D; n += 512) { float s = 0.f; for (int k = 0; k < D; ++k) s += bfu(GACT[(size_t)t * D + k]) * w_o[(size_t)k * D + n];
            chk_add(A, DN_ALPHA * X[(size_t)t * D + n] + MOD[(size_t)layer * 6144 + 4096 + n] * s, Z[(size_t)t * D + n]); }
        chk_end(A, tid, dbg, 12);
    }
}


__device__ __forceinline__ void check_post(KA a, unsigned char* ws, LAS unsigned char* lds, int tid, int layer) {
    float* dbg = (float*)(ws + WS_CTL + 4096) + layer * 16;
    ChkAcc A{(LAS float*)(lds + 0), (LAS unsigned*)(lds + 4), (LAS unsigned*)(lds + 8)};
    LAS float* red = (LAS float*)(lds + 64);
    const float* Z = (const float*)(ws + WS_Z); const float* MOD = (const float*)(ws + WS_MOD); const bool last = layer == DEPTH - 1;
    const float* XO = last ? a.out : (const float*)(ws + WS_X1); const bf16_t* HB = (const bf16_t*)(ws + WS_HB);
    for (int ti = 0; ti < 32; ++ti) {
        const int t = (int)(blockIdx.x + 256u * ti);
        __syncthreads(); if (tid == 0) { float s = 0.f; for (int k = 0; k < D; ++k) s += Z[(size_t)t * D + k]; const float mean = s / D; float q = 0.f; for (int k = 0; k < D; ++k) { const float d = Z[(size_t)t * D + k] - mean; q += d * d; }
            red[0] = mean; red[1] = 1.f / sqrtf(q / D + LN_EPS); } __syncthreads();
        const float mean = red[0], rstd = red[1];
        if (!last) { chk_begin(A, tid);
            for (int n = tid; n < D; n += 512) { const float y = (Z[(size_t)t * D + n] - mean) * rstd * a.in[4][layer * D + n] + a.in[5][layer * D + n]; chk_add(A, y, XO[(size_t)t * D + n]); }
            chk_end(A, tid, dbg, 13);
            chk_begin(A, tid);
            for (int n = tid; n < D; n += 512) { const float y = (Z[(size_t)t * D + n] - mean) * rstd * a.in[4][layer * D + n] + a.in[5][layer * D + n];
                chk_add(A, y * (1.f + MOD[(size_t)(layer + 1) * 6144 + 2048 + n]) + MOD[(size_t)(layer + 1) * 6144 + n], bfu(HB[(size_t)t * D + n])); }
            chk_end(A, tid, dbg, 14); }
    }
    if (layer == 0 && blockIdx.x == 0) {
        chk_begin(A, tid);
        for (int idx = tid; idx < 4 * 6144; idx += 512) { const int i = idx / 6144, n = idx % 6144; float s = a.in[3][idx];
            for (int k = 0; k < D; ++k) { const float cv = a.in[1][k]; s += cv / (1.f + expf(-cv)) * a.in[2][((size_t)i * D + k) * 6144 + n]; } chk_add(A, s, MOD[idx]); }
        chk_end(A, tid, dbg, 15);
    }
}
__device__ __forceinline__ void check_h0(KA a, unsigned char* ws, LAS unsigned char* lds, int tid) {
    float* dbg = (float*)(ws + WS_CTL + 4096);
    ChkAcc A{(LAS float*)(lds + 0), (LAS unsigned*)(lds + 4), (LAS unsigned*)(lds + 8)};
    const float* MOD = (const float*)(ws + WS_MOD); const bf16_t* HB = (const bf16_t*)(ws + WS_HB);
    chk_begin(A, tid);
    for (int ti = 0; ti < 32; ++ti) { const int t = (int)(blockIdx.x + 256u * ti);
        for (int n = tid; n < D; n += 512) chk_add(A, a.in[0][(size_t)t * D + n] * (1.f + MOD[2048 + n]) + MOD[n], bfu(HB[(size_t)t * D + n])); }
    chk_end(A, tid, dbg, 8);
}

enum PhaseKind { PK_P0 = 0, PK_P1, PK_DSA_IN, PK_DSA_Q, PK_DSA_SC, PK_DSA_ATT, PK_DSA_UV, PK_WO, PK_LN, PK_MOBA_IN, PK_MOBA_ATT };
constexpr int N_PHASES = 2 + 2 * 7 + 2 * 4;
__host__ __device__ constexpr int phase_kind(int ph, int& layer) {
    if (ph < 2) { layer = 0; return ph; }
    int p = ph - 2;
    for (int L = 0; L < DEPTH; ++L) {
        const int n = (L & 1) ? 4 : 7;
        if (p < n) { layer = L; if (L & 1) { constexpr int k[4] = {PK_MOBA_IN, PK_MOBA_ATT, PK_WO, PK_LN}; return k[p]; } else { constexpr int k[7] = {PK_DSA_IN, PK_DSA_Q, PK_DSA_SC, PK_DSA_ATT, PK_DSA_UV, PK_WO, PK_LN}; return k[p]; } }
        p -= n;
    }
    layer = 0; return -1;
}

template <bool COOP>
__global__ void __launch_bounds__(512, 2) mk_fwd(Args a0) {
    extern __shared__ __attribute__((aligned(16))) unsigned char lds_raw[];
    for (int ph = a0.ph_lo; ph < a0.ph_hi; ++ph) {
        const __attribute__((address_space(4))) Args* ka = (const __attribute__((address_space(4))) Args*)__builtin_amdgcn_kernarg_segment_ptr();
        asm volatile("" : "+s"(ka));
        KA a = *ka;
        int tid_ = threadIdx.x; asm volatile("" : "+v"(tid_));
        Ctx c;
        c.lds = (LAS unsigned char*)lds_raw;
        c.tid = tid_; c.lane = c.tid & 63; c.wave = __builtin_amdgcn_readfirstlane(c.tid >> 6);
        c.G = gridDim.x; { const int bx = blockIdx.x; c.vcu = (c.G % 8 == 0) ? (bx % 8) * (c.G / 8) + bx / 8 : bx; }
        c.gw = c.vcu * 8 + c.wave; c.NGW = c.G * 8;
        unsigned char* ws = a.ws;
        int layer = 0; const int kind = phase_kind(ph, layer); const int j = layer >> 1;
        unsigned char* wd = ws + WS_WD0 + (size_t)j * WD_SIZE; unsigned char* wm = ws + WS_WM0 + (size_t)j * WM_SIZE;
        pg8::StaticOrder so;
        switch (kind) {
        case PK_P0: if (EN(PK_P0)) { phase_p0(a, c); } break;
        case PK_P1: if (EN(PK_P1)) { phase_p1(a, c); } break;
        case PK_DSA_IN: if (EN(PK_DSA_IN)) {
            pg8::Gemm g{(const bf16_t*)(ws + WS_HB), (const bf16_t*)(wd + WD_WIN), S, DSA_INP, D, D, D, 0}; so.init(S, DSA_INP, c.G, (int)blockIdx.x);
            pg8::EpiDsaIn E{(bf16_t*)(ws + WU_CQ), (float*)(ws + WU_CKV), (bf16_t*)(ws + WU_KIDX), (float*)(ws + WS_WIDX), (bf16_t*)(ws + WS_SG), (float*)(ws + WS_SSQ)};
            pg8::gemm_phase(c.lds, c.tid, g, so, E); } break;
        case PK_DSA_Q: if (EN(PK_DSA_Q)) {
            pg8::Gemm g{(const bf16_t*)(ws + WU_CQ), (const bf16_t*)(wd + WD_W2), S, 6144, QR, QR, QR, 0}; so.init(S, 6144, c.G, (int)blockIdx.x);
            pg8::EpiDsaQ E{(bf16_t*)(ws + WU_QLAT), (bf16_t*)(ws + WU_QIDX), (const float*)(ws + WS_SSQ)};
            pg8::gemm_phase(c.lds, c.tid, g, so, E);
            dsa_ckv_norm(a, c, j); } break;
        case PK_DSA_SC: if (EN(PK_DSA_SC)) { phase_idx_scores(a, c); } break;
        case PK_DSA_ATT: if (EN(PK_DSA_ATT)) { phase_dsa_attn(a, c); } break;
        case PK_DSA_UV: if (EN(PK_DSA_UV)) {
            pg8::Gemm g{(const bf16_t*)(ws + WU_OLAT), (const bf16_t*)(wd + WD_WUV), S, D, 512, 4096, 512, 512}; so.init(S, D, c.G, (int)blockIdx.x);
            pg8::EpiUV E{(const bf16_t*)(ws + WS_SG), (bf16_t*)(ws + WS_GACT)};
            pg8::gemm_phase(c.lds, c.tid, g, so, E); } break;
        case PK_WO: if (EN(PK_WO)) {
            pg8::Gemm g{(const bf16_t*)(ws + WS_GACT), (const bf16_t*)((layer & 1) ? wm + WM_WO : wd + WD_WO), S, D, D, D, D, 0}; so.init(S, D, c.G, (int)blockIdx.x);
            pg8::EpiZ E{layer == 0 ? a.in[0] : (const float*)(ws + WS_X1), (const float*)(ws + WS_MOD) + (size_t)layer * 6144 + 4096, (float*)(ws + WS_Z)};
            pg8::gemm_phase(c.lds, c.tid, g, so, E); } break;
        case PK_LN: if (EN(PK_LN)) {
            phase_ln(a, c, layer); } break;
        case PK_MOBA_IN: if (EN(PK_MOBA_IN)) {
            pg8::Gemm g{(const bf16_t*)(ws + WS_HB), (const bf16_t*)(wm + WM_WIN), S, MOBA_IN, D, D, D, 0}; so.init(S, MOBA_IN, c.G, (int)blockIdx.x);
            pg8::EpiMobaIn E{(bf16_t*)(ws + WU_Q), (bf16_t*)(ws + WS_SG), (float*)(ws + WS_KMEAN) + (size_t)j * NH * 32 * HD};
            pg8::gemm_phase(c.lds, c.tid, g, so, E); } break;
        case PK_MOBA_ATT: if (EN(PK_MOBA_ATT)) { phase_moba_attn_v1(a, c, j); } break;
        default: break;
        }
        if (COOP) { if (ph + 1 < a0.ph_hi) cg::this_grid().sync(); }
    }
}

#if MK_CHECK
__global__ void __launch_bounds__(512, 1) chk_kernel(Args a0) {
    extern __shared__ __attribute__((aligned(16))) unsigned char lds_raw[];
    const __attribute__((address_space(4))) Args* ka = (const __attribute__((address_space(4))) Args*)__builtin_amdgcn_kernarg_segment_ptr();
    KA a = *ka;
    const int layer = a0.ph_lo, mode = a0.ph_hi;
    if (mode == 0) { if ((layer & 1) == 0) check_dsa(a, a0.ws, (LAS unsigned char*)lds_raw, (int)threadIdx.x, layer); else check_moba(a, a0.ws, (LAS unsigned char*)lds_raw, (int)threadIdx.x, layer); }
    else if (mode == 1) check_post(a, a0.ws, (LAS unsigned char*)lds_raw, (int)threadIdx.x, layer);
    else check_h0(a, a0.ws, (LAS unsigned char*)lds_raw, (int)threadIdx.x);
}
#endif
extern "C" void kernel_launch(void* const* d_in, const int* in_sizes, int n_in, void* d_out, int out_size, void* d_ws, size_t ws_size, hipStream_t stream) {
    static int grid = 0;
    if (grid == 0) {
        if (n_in != 16 || in_sizes[0] != S * D || out_size != S * D || ws_size < WS_END) {
            fprintf(stderr, "kernel_launch: unexpected shapes: n_in %d in0 %d out %d ws %zu (need %zu)\n", n_in, n_in > 0 ? in_sizes[0] : -1, out_size, ws_size, (size_t)WS_END); grid = -1; return; }
        int dev = 0, cus = 0, per_cu = 0;
        if (hipGetDevice(&dev) != hipSuccess || hipDeviceGetAttribute(&cus, hipDeviceAttributeMultiprocessorCount, dev) != hipSuccess) { grid = -1; return; }
        #if MK_ONE_LAUNCH
        const void* fn = (const void*)mk_fwd<true>;
#else
        const void* fn = (const void*)mk_fwd<false>;
#endif
        if (hipFuncSetAttribute(fn, hipFuncAttributeMaxDynamicSharedMemorySize, LDS_BYTES) != hipSuccess) { fprintf(stderr, "kernel_launch: hipFuncSetAttribute failed\n"); grid = -1; return; }
        if (hipOccupancyMaxActiveBlocksPerMultiprocessor(&per_cu, fn, 512, LDS_BYTES) != hipSuccess || per_cu < 1) { fprintf(stderr, "kernel_launch: occupancy query says %d blocks per CU\n", per_cu); per_cu = 1; }
        (void)hipGetLastError();
        grid = cus * 1;
    }
    if (grid < 0) return;
    Args a{};
    for (int i = 0; i < 16; ++i) a.in[i] = (const float*)d_in[i];
    a.out = (float*)d_out; a.ws = (unsigned char*)d_ws;
#if MK_ONE_LAUNCH
    a.ph_lo = 0; a.ph_hi = N_PHASES;
    void* params[] = {&a};
    hipError_t e = hipLaunchCooperativeKernel((const void*)mk_fwd<true>, dim3(grid), dim3(512), params, LDS_BYTES, stream);
    if (e != hipSuccess) fprintf(stderr, "kernel_launch: cooperative launch failed: %s (grid %d)\n", hipGetErrorString(e), grid);
#else
    for (int ph = 0; ph < N_PHASES; ++ph) {
#if MK_CHECK
        int layer_ = 0; const int kind_ = phase_kind(ph, layer_);
        { static bool once = false; if (!once) { once = true; (void)hipFuncSetAttribute((const void*)chk_kernel, hipFuncAttributeMaxDynamicSharedMemorySize, LDS_BYTES); } }
        if (kind_ == PK_LN) { a.ph_lo = layer_; a.ph_hi = 0; hipLaunchKernelGGL(chk_kernel, dim3(256), dim3(512), LDS_BYTES, stream, a); }
        if (ph == 2) { a.ph_lo = 0; a.ph_hi = 2; hipLaunchKernelGGL(chk_kernel, dim3(256), dim3(512), LDS_BYTES, stream, a); }
#endif
        a.ph_lo = ph; a.ph_hi = ph + 1;
        hipLaunchKernelGGL(mk_fwd<false>, dim3(grid), dim3(512), LDS_BYTES, stream, a);
#if MK_CHECK
        if (kind_ == PK_LN && layer_ < DEPTH - 1) { a.ph_lo = layer_; a.ph_hi = 1; hipLaunchKernelGGL(chk_kernel, dim3(256), dim3(512), LDS_BYTES, stream, a); }
#endif
    }
    const hipError_t le = hipPeekAtLastError();
    if (le != hipSuccess) fprintf(stderr, "kernel_launch: launch failed: %s\n", hipGetErrorName(le));
#endif
}
```

```cpp
#include <hip/hip_runtime.h>
#include <hip/hip_cooperative_groups.h>
#include <cstdio>
#include <cstdint>
namespace cg = cooperative_groups;

#ifndef MK_ONE_LAUNCH
#define MK_ONE_LAUNCH 1
#endif
#ifndef MK_ONLY
#define MK_ONLY -1
#endif
#define EN(k) (MK_ONLY < 0 || MK_ONLY == (k))
#ifndef MK_CHECK
#define MK_CHECK 0
#endif
#ifndef MK_CHECK_STAGE
#define MK_CHECK_STAGE -1
#endif
#ifndef MK_REP_KIND
#define MK_REP_KIND -1
#endif
constexpr int DBG_WORDS = 64;

#define LAS __attribute__((address_space(3)))
typedef unsigned short bf16_t;
typedef short bf16x8 __attribute__((ext_vector_type(8)));
typedef float f32x4 __attribute__((ext_vector_type(4)));
typedef float f32x16 __attribute__((ext_vector_type(16)));
typedef unsigned u32x4 __attribute__((ext_vector_type(4)));
typedef unsigned u32x2 __attribute__((ext_vector_type(2)));
typedef __bf16 bf2_t __attribute__((ext_vector_type(2)));

constexpr int S = 8192, D = 2048, NH = 16, HD = 128, QR = 512, KVR = 256, DEPTH = 4;
constexpr int DSA_IN = 2960, DSA_INP = 3072, MOBA_IN = 8192;
constexpr float LN_EPS = 1e-5f;
constexpr float DN_ALPHA = 1.6817928305074290f;
constexpr float QK_SCALE = 0.088388347648318440f;
constexpr float LOG2E = 1.4426950408889634f;

constexpr size_t MiB = 1u << 20;
constexpr size_t WS_CTL = 0;
constexpr size_t WS_MODP = 1 * MiB;
constexpr size_t WS_MOD = 3 * MiB;
constexpr size_t WS_KMEAN = 3 * MiB + 512 * 1024;
constexpr size_t WS_SSQ = 4 * MiB;
constexpr size_t WS_WIDX = 5 * MiB;
constexpr size_t WS_WGT = 8 * MiB;
constexpr size_t WD_WIN = 0, WD_W2 = (size_t)DSA_INP * D * 2, WD_WUV = WD_W2 + (size_t)6144 * 512 * 2, WD_WO = WD_WUV + (size_t)2048 * 512 * 2, WD_SIZE = WD_WO + (size_t)D * D * 2;
constexpr size_t WM_WIN = 0, WM_WO = (size_t)MOBA_IN * D * 2, WM_SIZE = WM_WO + (size_t)D * D * 2;
constexpr size_t WS_WD0 = WS_WGT, WS_WM0 = WS_WGT + 2 * WD_SIZE;
constexpr size_t WS_X1 = WS_WM0 + 2 * WM_SIZE;
constexpr size_t WS_Z = WS_X1 + 64 * MiB;
constexpr size_t WS_HB = WS_Z + 64 * MiB;
constexpr size_t WS_GACT = WS_HB + 32 * MiB;
constexpr size_t WS_SG = WS_GACT + 32 * MiB;
constexpr size_t WS_U = WS_SG + 32 * MiB;
constexpr size_t WU_CQ = WS_U, WU_CKV = WU_CQ + 8 * MiB, WU_CKVN = WU_CKV + 8 * MiB, WU_KIDX = WU_CKVN + 4 * MiB, WU_QLAT = WU_KIDX + 2 * MiB,
                 WU_QIDX = WU_QLAT + 64 * MiB, WU_SC = WU_QIDX + 32 * MiB, WU_OLAT = WU_SC + 128 * MiB, WU_DEND = WU_OLAT + 64 * MiB;
constexpr size_t WU_Q = WS_U, WU_K = WU_Q + 32 * MiB, WU_V = WU_K + 32 * MiB, WU_OPART = WU_V + 32 * MiB  , WU_ML = WU_OPART + 128 * MiB  ,
                 WU_LIST = WU_ML + 4 * MiB  , WU_MEND = WU_LIST + 8 * MiB;
constexpr size_t WS_CNT = 6 * MiB;
constexpr size_t WS_END = WU_DEND > WU_MEND ? WU_DEND : WU_MEND;
static_assert(WU_K == WU_Q + 32 * MiB && WU_V == WU_Q + 64 * MiB, "Q|K|V spacing");
static_assert(WD_SIZE == 28 * MiB && WM_SIZE == 40 * MiB && WS_X1 == 144 * MiB, "ws map");

constexpr int LDS_BYTES = 147456;

struct Args {
    const float* in[16];
    float* out;
    unsigned char* ws;
    int ph_lo, ph_hi;
};
typedef const __attribute__((address_space(4))) Args& KA;

__device__ __forceinline__ unsigned f2bf(float f) { unsigned u = __builtin_bit_cast(unsigned, f); return (u + 0x7fffu + ((u >> 16) & 1u)) >> 16; }
__device__ __forceinline__ unsigned pk2(float lo, float hi) { return f2bf(lo) | (f2bf(hi) << 16); }
__device__ __forceinline__ unsigned cvt_pk_bf16(float lo, float hi) { unsigned r; asm volatile("v_cvt_pk_bf16_f32 %0, %1, %2" : "=v"(r) : "v"(lo), "v"(hi)); return r; }
__device__ __forceinline__ float bf_lo(unsigned w) { return __builtin_bit_cast(float, w << 16); }
__device__ __forceinline__ float bf_hi(unsigned w) { return __builtin_bit_cast(float, w & 0xffff0000u); }
__device__ __forceinline__ float dot2bf(unsigned a, unsigned b, float c) { return __builtin_amdgcn_fdot2_f32_bf16(__builtin_bit_cast(bf2_t, a), __builtin_bit_cast(bf2_t, b), c, false); }
__device__ __forceinline__ float silu_f(float x) { return x * __builtin_amdgcn_rcpf(1.0f + __builtin_amdgcn_exp2f(-x * LOG2E)); }
__device__ __forceinline__ float wave_sum(float v) {
#pragma unroll
    for (int o = 1; o < 64; o <<= 1) v += __shfl_xor(v, o);
    return v;
}
__device__ __forceinline__ float wave_max(float v) {
#pragma unroll
    for (int o = 1; o < 64; o <<= 1) v = fmaxf(v, __shfl_xor(v, o));
    return v;
}
#define LDS_WAIT() asm volatile("s_waitcnt lgkmcnt(0)" ::: "memory")

namespace pg8 {
constexpr int BM = 256, BK = 64, HALF = 128, HTB = HALF * BK * 2, STAGE_BYTES = 8 * HTB, NXCD = 8, WGM = 8;
__host__ __device__ __forceinline__ int lds_byte(int r, int c) { const int st = (r >> 4) * 2 + (c >> 5), rr = r & 15, cc = c & 31, ob = rr * 64 + cc * 2; return st * 1024 + (ob ^ (((ob >> 9) & 1) << 5)); }
__host__ __device__ __forceinline__ void stage_rc(int b, int& R, int& C) { const int st = b / 1024, sb = b % 1024, swz = sb ^ (((sb >> 9) & 1) << 5); R = (st >> 1) * 16 + swz / 64; C = (st & 1) * 32 + (swz % 64) / 2; }
__host__ __device__ __forceinline__ int perm32(int rho) { const int n = rho >> 4, i = rho & 15; return 8 * (i >> 2) + 4 * n + (i & 3); }

struct Unit { int pm, pn; };
struct Gemm { const bf16_t* A; const bf16_t* Bt; int M, N, K, lda, ldb; long a_pn_off; };

struct StaticOrder {
    int nM, nN, nwg, G, c;
    __host__ __device__ void init(int M, int N, int G_, int c_) { nM = M / BM; nN = N / BM; nwg = nM * nN; G = G_; c = c_; }
    __host__ __device__ bool next(int i, Unit& u) const {
        const long L = (long)i * G + c; if (L >= nwg) return false;
        int wgid = (int)L; { const int q = nwg / NXCD, r = nwg % NXCD, xcd = wgid % NXCD, off = wgid / NXCD; wgid = (xcd < r ? xcd * (q + 1) : r * (q + 1) + (xcd - r) * q) + off; }
        const int nig = WGM * nN, gid = wgid / nig, fm = gid * WGM, gsz = (nM - fm) < WGM ? (nM - fm) : WGM;
        u.pm = fm + ((wgid % nig) % gsz); u.pn = (wgid % nig) / gsz; return true;
    }
};

template <class Epi>
__device__ __forceinline__ void gemm_phase(LAS unsigned char* lds, const int tid, const Gemm g, const StaticOrder& S, const Epi& E) {
    const int wid = __builtin_amdgcn_readfirstlane(tid >> 6), lane = tid & 63, wr = wid >> 2, wc = wid & 3, fr = lane & 15, fq = lane >> 4;
    const int K = g.K, nt = K / BK;
    unsigned voffA[2], voffB[2];
#pragma unroll
    for (int i = 0; i < 2; ++i) { int R, C; stage_rc(tid * 16 + i * 8192, R, C); const int Rb = Epi::PERM ? ((R & ~31) + perm32(R & 31)) : R;
        voffA[i] = (unsigned)(R * g.lda + C) * 2u; voffB[i] = (unsigned)(Rb * g.ldb + C) * 2u; }
    const size_t kstep = (size_t)(BK * 2);
    const size_t hstepA = (size_t)HALF * g.lda * 2, hstepB = (size_t)HALF * g.ldb * 2;
    const size_t tstepA = 2 * hstepA, tstepB = 2 * hstepB;
    const size_t pnA = (size_t)g.a_pn_off * 2;
    const unsigned ldsw = (unsigned)wid * 1024u;
    const int aoff = lds_byte(wr * 64 + fr, fq * 8), boff = lds_byte(wc * 32 + fr, fq * 8);
#define PG8_SA(b, h) (((b) * 2 + (h)) * HTB)
#define PG8_SB(b, h) ((4 + (b) * 2 + (h)) * HTB)
#define PG8_STAGE(bufoff, gbase, voff) do { _Pragma("unroll") for (int _i = 0; _i < 2; ++_i) \
        __builtin_amdgcn_global_load_lds((const unsigned*)((const char*)(gbase) + (voff)[_i]), (LAS unsigned*)(lds + (bufoff) + ldsw + _i * 8192), 16, 0, 0); } while (0)
#define PG8_LDA(dst, b, h) do { _Pragma("unroll") for (int m = 0; m < 4; ++m) _Pragma("unroll") for (int k = 0; k < 2; ++k) dst[m][k] = *(const LAS bf16x8*)(lds + PG8_SA(b, h) + aoff + m * 2048 + k * 1024); } while (0)
#define PG8_LDB(dst, b, h) do { _Pragma("unroll") for (int n = 0; n < 2; ++n) _Pragma("unroll") for (int k = 0; k < 2; ++k) dst[n][k] = *(const LAS bf16x8*)(lds + PG8_SB(b, h) + boff + n * 2048 + k * 1024); } while (0)
#define PG8_MMA(ai, bj, At, Bt) do { __builtin_amdgcn_s_setprio(1); _Pragma("unroll") for (int m = 0; m < 4; ++m) _Pragma("unroll") for (int n = 0; n < 2; ++n) _Pragma("unroll") for (int k = 0; k < 2; ++k) \
        acc[ai][bj][m][n] = __builtin_amdgcn_mfma_f32_16x16x32_bf16(Bt[n][k], At[m][k], acc[ai][bj][m][n], 0, 0, 0); __builtin_amdgcn_s_setprio(0); } while (0)
#define PG8_WAIT_V(n) asm volatile("s_waitcnt vmcnt(" #n ")" ::: "memory")
#define PG8_WAIT_L(n) asm volatile("s_waitcnt lgkmcnt(" #n ")" ::: "memory")
#define PG8_BAR __builtin_amdgcn_s_barrier()
#define PG8_SCHED __builtin_amdgcn_sched_barrier(0)
    Unit cur, nxt; int ui = 0;
    if (!S.next(0, cur)) return;
    f32x4 acc[2][2][4][2];
#pragma unroll
    for (int a = 0; a < 2; ++a)
#pragma unroll
        for (int b = 0; b < 2; ++b)
#pragma unroll
            for (int m = 0; m < 4; ++m)
#pragma unroll
                for (int n = 0; n < 2; ++n) acc[a][b][m][n] = (f32x4){0.f, 0.f, 0.f, 0.f};
    bf16x8 At[4][2], B0[2][2], B1[2][2];
    const char* cA = (const char*)g.A + (size_t)cur.pm * tstepA + (size_t)cur.pn * pnA; const char* cB = (const char*)g.Bt + (size_t)cur.pn * tstepB;
    PG8_STAGE(PG8_SB(0, 0), cB, voffB); PG8_STAGE(PG8_SB(0, 1), cB + hstepB, voffB); PG8_STAGE(PG8_SA(0, 0), cA, voffA); PG8_STAGE(PG8_SA(0, 1), cA + hstepA, voffA);
    if (wr == 1) PG8_BAR;
    PG8_WAIT_V(2); PG8_BAR;
    PG8_STAGE(PG8_SB(1, 0), cB + kstep, voffB); PG8_STAGE(PG8_SA(1, 0), cA + kstep, voffA); PG8_STAGE(PG8_SB(1, 1), cB + hstepB + kstep, voffB);
    PG8_WAIT_V(6); PG8_BAR;
    for (;;) {
        const bool has_next = S.next(ui + 1, nxt);
        const char* nA = has_next ? (const char*)g.A + (size_t)nxt.pm * tstepA + (size_t)nxt.pn * pnA : cA; const char* nB = has_next ? (const char*)g.Bt + (size_t)nxt.pn * tstepB : cB;
        for (int t = 0; t < nt; t += 2) {
            const bool last = (t == nt - 2);
            const char* a1 = cA + (size_t)(t + 1) * kstep;
            const char* a2 = last ? nA : cA + (size_t)(t + 2) * kstep; const char* b2 = last ? nB : cB + (size_t)(t + 2) * kstep;
            const char* a3 = a2 + kstep; const char* b3 = b2 + kstep;
            PG8_LDB(B0, 0, 0); PG8_LDB(B1, 0, 1); PG8_SCHED; PG8_LDA(At, 0, 0); PG8_STAGE(PG8_SA(1, 1), a1 + hstepA, voffA);
            PG8_WAIT_V(8); PG8_WAIT_L(0); PG8_BAR; PG8_MMA(0, 0, At, B0); PG8_MMA(0, 1, At, B1); PG8_BAR; PG8_SCHED;
            PG8_LDA(At, 0, 1); PG8_STAGE(PG8_SB(0, 0), b2, voffB); PG8_STAGE(PG8_SB(0, 1), b2 + hstepB, voffB); PG8_STAGE(PG8_SA(0, 0), a2, voffA);
            PG8_WAIT_V(8); PG8_WAIT_L(0); PG8_BAR; PG8_MMA(1, 0, At, B0); PG8_MMA(1, 1, At, B1); PG8_BAR; PG8_SCHED;
            PG8_LDB(B0, 1, 0); PG8_LDB(B1, 1, 1); PG8_SCHED; PG8_LDA(At, 1, 0); PG8_STAGE(PG8_SA(0, 1), a2 + hstepA, voffA);
            PG8_WAIT_V(8); PG8_WAIT_L(0); PG8_BAR; PG8_MMA(0, 0, At, B0); PG8_MMA(0, 1, At, B1); PG8_BAR; PG8_SCHED;
            PG8_LDA(At, 1, 1); PG8_STAGE(PG8_SB(1, 0), b3, voffB); PG8_STAGE(PG8_SB(1, 1), b3 + hstepB, voffB); PG8_STAGE(PG8_SA(1, 0), a3, voffA);
            PG8_WAIT_V(8); PG8_WAIT_L(0); PG8_BAR; PG8_MMA(1, 0, At, B0); PG8_MMA(1, 1, At, B1); PG8_BAR; PG8_SCHED;
        }
        if (wr == 0) PG8_BAR;
        E(acc, cur, wr, wc, fr, fq);
        if (!has_next) break;
#pragma unroll
        for (int a = 0; a < 2; ++a)
#pragma unroll
            for (int b = 0; b < 2; ++b)
#pragma unroll
                for (int m = 0; m < 4; ++m)
#pragma unroll
                    for (int n = 0; n < 2; ++n) acc[a][b][m][n] = (f32x4){0.f, 0.f, 0.f, 0.f};
        cur = nxt; cA = nA; cB = nB; ++ui;
        if (wr == 1) PG8_BAR;
    }
    PG8_WAIT_V(0);
    PG8_BAR;
#undef PG8_SA
#undef PG8_SB
#undef PG8_STAGE
#undef PG8_LDA
#undef PG8_LDB
#undef PG8_MMA
#undef PG8_WAIT_V
#undef PG8_WAIT_L
#undef PG8_BAR
#undef PG8_SCHED
}

__device__ __forceinline__ u32x4 pack8(f32x4 v0, f32x4 v1) { u32x4 w; w.x = cvt_pk_bf16(v0[0], v0[1]); w.y = cvt_pk_bf16(v0[2], v0[3]); w.z = cvt_pk_bf16(v1[0], v1[1]); w.w = cvt_pk_bf16(v1[2], v1[3]); return w; }

struct EpiDsaIn {
    static constexpr bool PERM = true;
    bf16_t* CQ; float* CKV; bf16_t* KIDX; float* WIDX; bf16_t* SG; float* SSQ;
    __device__ __forceinline__ void operator()(const f32x4 (&acc)[2][2][4][2], const Unit& u, int wr, int wc, int fr, int fq) const {
        const int row0 = u.pm * BM + wr * 64 + fr, pn = u.pn, cw = wc * 32 + 8 * fq;
        if (pn < 3) {
#pragma unroll
            for (int ai = 0; ai < 2; ++ai)
#pragma unroll
                for (int m = 0; m < 4; ++m) { const int row = row0 + ai * HALF + m * 16; float s = 0.f;
#pragma unroll
                    for (int bj = 0; bj < 2; ++bj) { const f32x4 v0 = acc[ai][bj][m][0], v1 = acc[ai][bj][m][1];
                        s += (v0[0] * v0[0] + v0[1] * v0[1]) + (v0[2] * v0[2] + v0[3] * v0[3]) + (v1[0] * v1[0] + v1[1] * v1[1]) + (v1[2] * v1[2] + v1[3] * v1[3]);
                        if (pn < 2) *(u32x4*)(CQ + (size_t)row * QR + pn * 256 + bj * HALF + cw) = pack8(v0, v1);
                        else { float* p = CKV + (size_t)row * KVR + bj * HALF + cw; *(f32x4*)p = v0; *(f32x4*)(p + 4) = v1; } }
                    s += __shfl_xor(s, 16); s += __shfl_xor(s, 32);
                    if (fq == 0) SSQ[(size_t)row * 12 + (pn < 2 ? pn * 4 : 8) + wc] = s; }
        } else if (pn == 3) {
#pragma unroll
            for (int ai = 0; ai < 2; ++ai)
#pragma unroll
                for (int m = 0; m < 4; ++m) { const int row = row0 + ai * HALF + m * 16;
                    *(u32x4*)(KIDX + (size_t)row * 128 + cw) = pack8(acc[ai][0][m][0], acc[ai][0][m][1]);
                    if (wc == 0 && fq < 2) { float* p = WIDX + (size_t)row * 16 + 8 * fq; *(f32x4*)p = acc[ai][1][m][0] * 0.25f; *(f32x4*)(p + 4) = acc[ai][1][m][1] * 0.25f; } }
        } else {
#pragma unroll
            for (int ai = 0; ai < 2; ++ai)
#pragma unroll
                for (int m = 0; m < 4; ++m) { const int row = row0 + ai * HALF + m * 16;
#pragma unroll
                    for (int bj = 0; bj < 2; ++bj) { f32x4 v0 = acc[ai][bj][m][0], v1 = acc[ai][bj][m][1];
#pragma unroll
                        for (int j = 0; j < 4; ++j) { v0[j] = silu_f(v0[j]); v1[j] = silu_f(v1[j]); }
                        *(u32x4*)(SG + (size_t)row * D + (pn - 4) * 256 + bj * HALF + cw) = pack8(v0, v1); } }
        }
    }
};
struct EpiDsaQ {
    static constexpr bool PERM = true;
    bf16_t* QLAT; bf16_t* QIDX; const float* SSQ;
    __device__ __forceinline__ void operator()(const f32x4 (&acc)[2][2][4][2], const Unit& u, int wr, int wc, int fr, int fq) const {
        const int row0 = u.pm * BM + wr * 64 + fr, pn = u.pn, cw = wc * 32 + 8 * fq;
#pragma unroll
        for (int ai = 0; ai < 2; ++ai)
#pragma unroll
            for (int m = 0; m < 4; ++m) { const int row = row0 + ai * HALF + m * 16;
                const f32x4 p0 = *(const f32x4*)(SSQ + (size_t)row * 12), p1 = *(const f32x4*)(SSQ + (size_t)row * 12 + 4);
                const float ss = ((p0[0] + p0[1]) + (p0[2] + p0[3])) + ((p1[0] + p1[1]) + (p1[2] + p1[3]));
                const float rs = __builtin_amdgcn_rsqf(ss * (1.0f / QR) + LN_EPS);
                bf16_t* dst = pn < 16 ? QLAT + (size_t)row * 4096 + pn * 256 : QIDX + (size_t)row * 2048 + (pn - 16) * 256;
#pragma unroll
                for (int bj = 0; bj < 2; ++bj) *(u32x4*)(dst + bj * HALF + cw) = pack8(acc[ai][bj][m][0] * rs, acc[ai][bj][m][1] * rs); }
    }
};
struct EpiUV {
    static constexpr bool PERM = true;
    const bf16_t* SG; bf16_t* GACT;
    __device__ __forceinline__ void operator()(const f32x4 (&acc)[2][2][4][2], const Unit& u, int wr, int wc, int fr, int fq) const {
        const int row0 = u.pm * BM + wr * 64 + fr, cw = u.pn * BM + wc * 32 + 8 * fq;
#pragma unroll
        for (int ai = 0; ai < 2; ++ai)
#pragma unroll
            for (int m = 0; m < 4; ++m) { const size_t off = (size_t)(row0 + ai * HALF + m * 16) * D + cw;
#pragma unroll
                for (int bj = 0; bj < 2; ++bj) { const u32x4 g = *(const u32x4*)(SG + off + bj * HALF);
                    f32x4 v0 = acc[ai][bj][m][0], v1 = acc[ai][bj][m][1];
                    v0[0] *= bf_lo(g.x); v0[1] *= bf_hi(g.x); v0[2] *= bf_lo(g.y); v0[3] *= bf_hi(g.y);
                    v1[0] *= bf_lo(g.z); v1[1] *= bf_hi(g.z); v1[2] *= bf_lo(g.w); v1[3] *= bf_hi(g.w);
                    *(u32x4*)(GACT + off + bj * HALF) = pack8(v0, v1); } }
    }
};
struct EpiZ {
    static constexpr bool PERM = false;
    const float* X; const float* GM; float* Z;
    __device__ __forceinline__ void operator()(const f32x4 (&acc)[2][2][4][2], const Unit& u, int wr, int wc, int fr, int fq) const {
        const int row0 = u.pm * BM + wr * 64 + fr, col0 = u.pn * BM + wc * 32 + 4 * fq;
        f32x4 gm[2][2];
#pragma unroll
        for (int bj = 0; bj < 2; ++bj)
#pragma unroll
            for (int n = 0; n < 2; ++n) gm[bj][n] = *(const f32x4*)(GM + col0 + bj * HALF + n * 16);
#pragma unroll
        for (int ai = 0; ai < 2; ++ai)
#pragma unroll
            for (int m = 0; m < 4; ++m) { const size_t off = (size_t)(row0 + ai * HALF + m * 16) * D + col0;
#pragma unroll
                for (int bj = 0; bj < 2; ++bj)
#pragma unroll
                    for (int n = 0; n < 2; ++n) { const f32x4 xv = *(const f32x4*)(X + off + bj * HALF + n * 16);
                        *(f32x4*)(Z + off + bj * HALF + n * 16) = xv * DN_ALPHA + gm[bj][n] * acc[ai][bj][m][n]; } }
    }
};
struct EpiMobaIn {
    static constexpr bool PERM = true;
    bf16_t* Q; bf16_t* SG; float* KMEAN;
    __device__ __forceinline__ void operator()(const f32x4 (&acc)[2][2][4][2], const Unit& u, int wr, int wc, int fr, int fq) const {
        const int row0 = u.pm * BM + wr * 64 + fr, pn = u.pn, cw = (pn & 7) * 256 + wc * 32 + 8 * fq;
        if (pn < 24) {
            bf16_t* dst = Q + (size_t)(pn >> 3) * (size_t)(16u << 20);
#pragma unroll
            for (int ai = 0; ai < 2; ++ai)
#pragma unroll
                for (int m = 0; m < 4; ++m) { const size_t off = (size_t)(row0 + ai * HALF + m * 16) * D + cw;
#pragma unroll
                    for (int bj = 0; bj < 2; ++bj) *(u32x4*)(dst + off + bj * HALF) = pack8(acc[ai][bj][m][0], acc[ai][bj][m][1]); }
            if (pn >= 8 && pn < 16) {
#pragma unroll
                for (int bj = 0; bj < 2; ++bj)
#pragma unroll
                    for (int n = 0; n < 2; ++n) {
                        float c0 = 0.f, c1 = 0.f, c2 = 0.f, c3 = 0.f;
#pragma unroll
                        for (int ai = 0; ai < 2; ++ai)
#pragma unroll
                            for (int m = 0; m < 4; ++m) { const f32x4 v = acc[ai][bj][m][n]; c0 += v[0]; c1 += v[1]; c2 += v[2]; c3 += v[3]; }
#pragma unroll
                        for (int o = 1; o < 16; o <<= 1) { c0 += __shfl_xor(c0, o); c1 += __shfl_xor(c1, o); c2 += __shfl_xor(c2, o); c3 += __shfl_xor(c3, o); }
                        if (fr == 0) { const int col = cw + bj * HALF + 4 * n; float* p = KMEAN + ((size_t)(col >> 7) * 32 + u.pm) * 128 + (col & 127);
                            atomicAdd(p, c0 * (1.0f / 256.0f)); atomicAdd(p + 1, c1 * (1.0f / 256.0f)); atomicAdd(p + 2, c2 * (1.0f / 256.0f)); atomicAdd(p + 3, c3 * (1.0f / 256.0f)); } }
            }
        } else {
#pragma unroll
            for (int ai = 0; ai < 2; ++ai)
#pragma unroll
                for (int m = 0; m < 4; ++m) { const size_t off = (size_t)(row0 + ai * HALF + m * 16) * D + cw;
#pragma unroll
                    for (int bj = 0; bj < 2; ++bj) { f32x4 v0 = acc[ai][bj][m][0], v1 = acc[ai][bj][m][1];
#pragma unroll
                        for (int j = 0; j < 4; ++j) { v0[j] = silu_f(v0[j]); v1[j] = silu_f(v1[j]); }
                        *(u32x4*)(SG + off + bj * HALF) = pack8(v0, v1); } }
        }
    }
};
}

struct Ctx {
    LAS unsigned char* lds;
    int tid, lane, wave, vcu, G, gw, NGW;
};

template <bool HAS_RS>
__device__ __forceinline__ void cvt_item(const float* src, int ld_src, int n_src0, int nvalid, int k0, bf16_t* dst, int ld_dst, int n_dst0, int kd0, int kz0,
                                         const float* rowscale, float cscale, LAS float* scr, int lane) {
    const int n = lane & 31, kh = lane >> 5;
    float v[32];
    if (nvalid > 0) {
        const int nn = n < nvalid ? n : nvalid - 1; const float mk = n < nvalid ? cscale : 0.f;
        const float* p = src + (size_t)(k0 + kh) * ld_src + n_src0 + nn;
#pragma unroll
        for (int i = 0; i < 32; ++i) v[i] = p[(size_t)(2 * i) * ld_src];
#pragma unroll
        for (int i = 0; i < 32; ++i) { float x = v[i] * mk; if (HAS_RS) x *= rowscale[k0 + 2 * i + kh]; scr[(2 * i + kh) * 33 + n] = x; }
    } else {
#pragma unroll
        for (int i = 0; i < 32; ++i) scr[(2 * i + kh) * 33 + n] = 0.f;
    }
    LDS_WAIT(); asm volatile("" ::: "memory");
    const int c = lane & 7;
#pragma unroll
    for (int j = 0; j < 4; ++j) { const int nr = (lane >> 3) + 8 * j; const LAS float* s = scr + (8 * c) * 33 + nr;
        u32x4 o; o.x = pk2(s[0 * 33], s[1 * 33]); o.y = pk2(s[2 * 33], s[3 * 33]); o.z = pk2(s[4 * 33], s[5 * 33]); o.w = pk2(s[6 * 33], s[7 * 33]);
        *(u32x4*)(dst + (size_t)(n_dst0 + nr) * ld_dst + kd0 + 8 * c) = o;
        if (kz0 >= 0) *(u32x4*)(dst + (size_t)(n_dst0 + nr) * ld_dst + kz0 + 8 * c) = (u32x4){0u, 0u, 0u, 0u}; }
    LDS_WAIT(); asm volatile("" ::: "memory");
}

__device__ __forceinline__ void phase_p0(KA a, const Ctx& c) {
    unsigned char* ws = a.ws;
    {
        const float* cvec = a.in[1]; const float* ada_w = a.in[2]; float* MODP = (float*)(ws + WS_MODP);
        for (int task = c.gw; task < 4 * 16 * 24; task += c.NGW) {
            const int nc = task % 24, kc = (task / 24) % 16, i = task / (24 * 16);
            const float* w = ada_w + ((size_t)i * 2048 + kc * 128) * 6144 + nc * 256 + c.lane * 4;
            f32x4 acc = (f32x4){0.f, 0.f, 0.f, 0.f};
#pragma unroll 16
            for (int k = 0; k < 128; ++k) { const float cv = cvec[kc * 128 + k]; const float sv = silu_f(cv); const f32x4 v = *(const f32x4*)(w + (size_t)k * 6144); acc += v * sv; }
            *(f32x4*)(MODP + (size_t)(kc * 4 + i) * 6144 + nc * 256 + c.lane * 4) = acc;
        }
    }
    {
        LAS float* scr = (LAS float*)(c.lds + c.wave * 8704);
        constexpr int I_A = 32 * 32, I_B = 64 * 32, I_C = 64 * 8, I_D = 16 * 4 * 4, I_E = 64 * 32, I_DSA = I_A + I_B + I_C + I_D + I_E;
        constexpr int I_F = 256 * 32, I_G = 64 * 32, I_MOBA = I_F + I_G, I_ALL = 2 * I_DSA + 2 * I_MOBA;
        for (int it = c.gw; it < I_ALL; it += c.NGW) {
            if (it < 2 * I_DSA) {
                const int j = it / I_DSA; int r = it % I_DSA; unsigned char* wd = ws + WS_WD0 + (size_t)j * WD_SIZE;
                if (r < I_A + I_B) {
                    const int nb = r >> 5, kb = r & 31; const float* src = a.in[6] + (size_t)j * D * DSA_IN;
                    int n_src0, nvalid; if (nb < 32) { n_src0 = nb * 32; nvalid = 912 - n_src0; nvalid = nvalid < 0 ? 0 : (nvalid > 32 ? 32 : nvalid); } else { n_src0 = 912 + (nb - 32) * 32; nvalid = 32; }
                    cvt_item<false>(src, DSA_IN, n_src0, nvalid, kb * 64, (bf16_t*)(wd + WD_WIN), D, nb * 32, kb * 64, -1, nullptr, 1.0f, scr, c.lane);
                    continue; }
                r -= I_A + I_B;
                if (r < I_C) {
                    const int nb = r >> 3, kb = r & 7; const float* src = a.in[10] + (size_t)j * QR * 2048;
                    cvt_item<true>(src, 2048, nb * 32, 32, kb * 64, (bf16_t*)(wd + WD_W2), QR, 4096 + nb * 32, kb * 64, -1, a.in[7] + j * QR, QK_SCALE, scr, c.lane);
                    continue; }
                r -= I_C;
                if (r < I_D) {
                    const int h = r >> 4, nb = (r >> 2) & 3, kb = r & 3; const float* src = a.in[12] + ((size_t)j * NH + h) * KVR * HD;
                    cvt_item<false>(src, HD, nb * 32, 32, kb * 64, (bf16_t*)(wd + WD_WUV), 512, h * HD + nb * 32, (h & 1) * 256 + kb * 64, ((h & 1) ^ 1) * 256 + kb * 64, nullptr, 1.0f, scr, c.lane);
                    continue; }
                r -= I_D;
                { const int nb = r >> 5, kb = r & 31; const float* src = a.in[13] + (size_t)j * D * D;
                  cvt_item<false>(src, D, nb * 32, 32, kb * 64, (bf16_t*)(wd + WD_WO), D, nb * 32, kb * 64, -1, nullptr, 1.0f, scr, c.lane); }
            } else {
                const int q = it - 2 * I_DSA, j = q / I_MOBA; int r = q % I_MOBA; unsigned char* wm = ws + WS_WM0 + (size_t)j * WM_SIZE;
                if (r < I_F) { const int nb = r >> 5, kb = r & 31; const float* src = a.in[14] + (size_t)j * D * MOBA_IN;
                    cvt_item<false>(src, MOBA_IN, nb * 32, 32, kb * 64, (bf16_t*)(wm + WM_WIN), D, nb * 32, kb * 64, -1, nullptr, 1.0f, scr, c.lane); }
                else { r -= I_F; const int nb = r >> 5, kb = r & 31; const float* src = a.in[15] + (size_t)j * D * D;
                    cvt_item<false>(src, D, nb * 32, 32, kb * 64, (bf16_t*)(wm + WM_WO), D, nb * 32, kb * 64, -1, nullptr, 1.0f, scr, c.lane); }
            }
        }
    }
    for (int it = c.vcu; it < 2048; it += c.G) {
        const int j = it >> 10, h = (it >> 6) & 15, k0 = (it & 63) * 8, cc = c.tid & 255, kh = c.tid >> 8;
        const float* uq = a.in[9] + (size_t)j * QR * 2048 + (size_t)(k0 + 4 * kh) * 2048 + h * HD;
        const float* uk = a.in[11] + ((size_t)j * NH + h) * HD * KVR + cc;
        float acc[4] = {0.f, 0.f, 0.f, 0.f};
#pragma unroll 8
        for (int d = 0; d < HD; ++d) { const float b = uk[d * KVR];
#pragma unroll
            for (int i = 0; i < 4; ++i) acc[i] += uq[i * 2048 + d] * b; }
        const float* gq = a.in[7] + j * QR + k0 + 4 * kh;
        u32x2 o; o.x = pk2(acc[0] * gq[0] * QK_SCALE, acc[1] * gq[1] * QK_SCALE); o.y = pk2(acc[2] * gq[2] * QK_SCALE, acc[3] * gq[3] * QK_SCALE);
        *(u32x2*)((bf16_t*)(ws + WS_WD0 + (size_t)j * WD_SIZE + WD_W2) + (size_t)(h * KVR + cc) * QR + k0 + 4 * kh) = o;
    }
#if MK_CHECK
    if (c.vcu == 0 && c.tid < DBG_WORDS) ((float*)(ws + WS_CTL + 4096))[c.tid] = 0.f;
#endif
    { float* km = (float*)(ws + WS_KMEAN); for (int i = c.vcu * 512 + c.tid; i < 2 * NH * 32 * HD; i += c.G * 512) km[i] = 0.f; }
    if (c.vcu == 1) { int* cn = (int*)(ws + WS_CNT); for (int i = c.tid; i < 2 * NH * 32; i += 512) cn[i] = 0; }
}

__device__ __forceinline__ void phase_p1(KA a, const Ctx& c) {
    unsigned char* ws = a.ws; const float* MODP = (const float*)(ws + WS_MODP); const float* ada_b = a.in[3];
    LAS float* tab = (LAS float*)c.lds;
    for (int n = c.tid; n < 4096; n += 512) { float s = ada_b[n];
#pragma unroll
        for (int kc = 0; kc < 16; ++kc) s += MODP[(size_t)(kc * 4 + 0) * 6144 + n];
        tab[n] = n >= 2048 ? 1.0f + s : s; }
    if (c.vcu < 96 && c.tid < 256) { const int idx = c.vcu * 256 + c.tid, i = idx / 6144, n = idx % 6144; float s = ada_b[idx];
#pragma unroll
        for (int kc = 0; kc < 16; ++kc) s += MODP[(size_t)(kc * 4 + i) * 6144 + n];
        ((float*)(ws + WS_MOD))[idx] = s; }
    __syncthreads();
    const float* x = a.in[0]; bf16_t* HB = (bf16_t*)(ws + WS_HB);
    for (int t = c.gw; t < S; t += c.NGW) {
#pragma unroll
        for (int j = 0; j < 8; ++j) { const int col = 4 * c.lane + 256 * j; const f32x4 xv = *(const f32x4*)(x + (size_t)t * D + col);
            const f32x4 sh = *(const LAS f32x4*)(tab + col), sc = *(const LAS f32x4*)(tab + 2048 + col); const f32x4 hv = xv * sc + sh;
            u32x2 o; o.x = pk2(hv[0], hv[1]); o.y = pk2(hv[2], hv[3]); *(u32x2*)(HB + (size_t)t * D + col) = o; }
    }
    __syncthreads();
}

__device__ __forceinline__ void phase_ln(KA a, const Ctx& c, int layer) {
    unsigned char* ws = a.ws; const float* Z = (const float*)(ws + WS_Z); const bool last = layer == DEPTH - 1;
    float* XO = last ? a.out : (float*)(ws + WS_X1); bf16_t* HB = (bf16_t*)(ws + WS_HB);
    const float* g = a.in[4] + layer * D; const float* b = a.in[5] + layer * D;
    const float* modn = (const float*)(ws + WS_MOD) + (size_t)(last ? layer : layer + 1) * 6144;
    float chk_off = 0.f;
#if MK_CHECK
    if (last) { const float* dbg = (const float*)(ws + WS_CTL + 4096);
        if (MK_CHECK_STAGE >= 0) chk_off = dbg[MK_CHECK_STAGE < 0 ? 0 : MK_CHECK_STAGE];
        else { float best = 0.f; int bi = 0; for (int i = 1; i < DBG_WORDS; ++i) if (dbg[i] > best) { best = dbg[i]; bi = i; } chk_off = MK_CHECK_STAGE == -1 ? floorf(fminf(best, 10.f) * 16.f + 0.5f) * (1.f / 16.f) : (float)bi; } }
#endif
    for (int t = c.gw; t < S; t += c.NGW) {
        f32x4 v[8]; float s = 0.f;
#pragma unroll
        for (int j = 0; j < 8; ++j) { v[j] = *(const f32x4*)(Z + (size_t)t * D + 4 * c.lane + 256 * j); s += (v[j][0] + v[j][1]) + (v[j][2] + v[j][3]); }
        const float mean = wave_sum(s) * (1.0f / D); float q = 0.f;
#pragma unroll
        for (int j = 0; j < 8; ++j) { v[j] = v[j] - mean; q += (v[j][0] * v[j][0] + v[j][1] * v[j][1]) + (v[j][2] * v[j][2] + v[j][3] * v[j][3]); }
        const float rstd = 1.0f / sqrtf(wave_sum(q) * (1.0f / D) + LN_EPS);
#pragma unroll
        for (int j = 0; j < 8; ++j) { const int col = 4 * c.lane + 256 * j; const f32x4 gv = *(const f32x4*)(g + col), bv = *(const f32x4*)(b + col);
            const f32x4 y = v[j] * rstd * gv + bv; *(f32x4*)(XO + (size_t)t * D + col) = y + chk_off;
            if (!last) { const f32x4 sh = *(const f32x4*)(modn + col), sc = *(const f32x4*)(modn + 2048 + col); const f32x4 hv = y * (sc + 1.0f) + sh;
                u32x2 o; o.x = pk2(hv[0], hv[1]); o.y = pk2(hv[2], hv[3]); *(u32x2*)(HB + (size_t)t * D + col) = o; } }
    }
}

__device__ __forceinline__ void dsa_ckv_norm(KA a, const Ctx& c, int j) {
    unsigned char* ws = a.ws; const float* CKV = (const float*)(ws + WU_CKV); bf16_t* CKVN = (bf16_t*)(ws + WU_CKVN); const float* SSQ = (const float*)(ws + WS_SSQ);
    const float* gkv = a.in[8] + j * KVR; const f32x4 gv = *(const f32x4*)(gkv + 4 * c.lane);
    for (int t = c.gw; t < S; t += c.NGW) {
        const f32x4 p = *(const f32x4*)(SSQ + (size_t)t * 12 + 8); const float rs = __builtin_amdgcn_rsqf(((p[0] + p[1]) + (p[2] + p[3])) * (1.0f / KVR) + LN_EPS);
        const f32x4 v = *(const f32x4*)(CKV + (size_t)t * KVR + 4 * c.lane) * rs * gv;
        u32x2 o; o.x = pk2(v[0], v[1]); o.y = pk2(v[2], v[3]); *(u32x2*)(CKVN + (size_t)t * KVR + 4 * c.lane) = o;
    }
}

__device__ __forceinline__ int idx_base(int qt) { const int a = qt >> 2, b = qt & 3; return (a + 1) * (2 * a + b); }
__device__ __forceinline__ void phase_idx_scores(KA a, const Ctx& c) {
    unsigned char* ws = a.ws; const bf16_t* QIDX = (const bf16_t*)(ws + WU_QIDX); const bf16_t* KIDX = (const bf16_t*)(ws + WU_KIDX); const float* WIDX = (const float*)(ws + WS_WIDX);
    _Float16* SC = (_Float16*)(ws + WU_SC);
    LAS float* WL = (LAS float*)(c.lds + 65536) + c.wave * 64;
    constexpr int NIT = 8320;
    const int L0 = (int)((long)NIT * c.vcu / c.G), L1 = (int)((long)NIT * (c.vcu + 1) / c.G);
    if (L0 >= L1) return;
    int qt = 0; while (idx_base(qt + 1) <= L0) ++qt;
    int kt = L0 - idx_base(qt), cur_qt = -1;
    const int lane = c.lane, r = lane & 31, hk = lane >> 5, rq = (r >> 2) & 1, head = (r & 3) + 4 * (r >> 3);
    bf16x8 qa[2][8];
    u32x4 st[4];
#define IDX_LOAD(KT_) do { _Pragma("unroll") for (int i = 0; i < 4; ++i) { const int id = c.tid + 512 * i; st[i] = *(const u32x4*)(KIDX + (size_t)(128 * (KT_) + (id >> 4)) * 128 + (id & 15) * 8); } } while (0)
#define IDX_WRITE(BUF_) do { _Pragma("unroll") for (int i = 0; i < 4; ++i) { const int id = c.tid + 512 * i, key = id >> 4, ch = id & 15; \
        *(LAS u32x4*)(c.lds + (BUF_) * 32768 + key * 256 + ((ch ^ ((key >> 2) & 15)) << 4)) = st[i]; } } while (0)
    IDX_LOAD(kt); IDX_WRITE(0);
    for (int L = L0; L < L1; ++L) {
        const int cur = (L - L0) & 1;
        if (qt != cur_qt) {
            cur_qt = qt;
#pragma unroll
            for (int rt = 0; rt < 2; ++rt) { const bf16_t* p = QIDX + (size_t)(32 * qt + 4 * c.wave + 2 * rt + rq) * 2048 + head * 128 + 8 * hk;
#pragma unroll
                for (int ks = 0; ks < 8; ++ks) qa[rt][ks] = *(const bf16x8*)(p + 16 * ks); }
            WL[lane] = WIDX[(size_t)(32 * qt + 4 * c.wave + (lane >> 4)) * 16 + (lane & 15)];
        }
        __syncthreads();
        int nqt = qt, nkt = kt + 1; if (nkt > (qt >> 2)) { nqt = qt + 1; nkt = 0; }
        const bool more = L + 1 < L1;
        if (more) IDX_LOAD(nkt);
        LAS unsigned char* KT = c.lds + cur * 32768;
        float sa0 = 0.f, sa1 = 0.f, sa2 = 0.f, sa3 = 0.f, sb0 = 0.f, sb1 = 0.f, sb2 = 0.f, sb3 = 0.f;
#pragma unroll 1
        for (int cc = 0; cc < 4; ++cc) {
            bf16x8 bfr[8];
#pragma unroll
            for (int ks = 0; ks < 8; ++ks) bfr[ks] = *(const LAS bf16x8*)(KT + (4 * r + cc) * 256 + (((ks * 2 + hk) ^ (r & 15)) << 4));
            f32x16 acc0 = {}, acc1 = {};
#pragma unroll
            for (int ks = 0; ks < 8; ++ks) { acc0 = __builtin_amdgcn_mfma_f32_32x32x16_bf16(qa[0][ks], bfr[ks], acc0, 0, 0, 0);
                acc1 = __builtin_amdgcn_mfma_f32_32x32x16_bf16(qa[1][ks], bfr[ks], acc1, 0, 0, 0); }
            float s0 = 0.f, s1 = 0.f;
            { const LAS f32x4* wp = (const LAS f32x4*)(WL + hk * 16);
#pragma unroll
              for (int q4 = 0; q4 < 4; ++q4) { const f32x4 w = wp[q4];
#pragma unroll
                  for (int e = 0; e < 4; ++e) s0 += w[e] * fmaxf(acc0[4 * q4 + e], 0.f); } }
            { const LAS f32x4* wp = (const LAS f32x4*)(WL + (2 + hk) * 16);
#pragma unroll
              for (int q4 = 0; q4 < 4; ++q4) { const f32x4 w = wp[q4];
#pragma unroll
                  for (int e = 0; e < 4; ++e) s1 += w[e] * fmaxf(acc1[4 * q4 + e], 0.f); } }
            sa0 = cc == 0 ? s0 : sa0; sa1 = cc == 1 ? s0 : sa1; sa2 = cc == 2 ? s0 : sa2; sa3 = cc == 3 ? s0 : sa3;
            sb0 = cc == 0 ? s1 : sb0; sb1 = cc == 1 ? s1 : sb1; sb2 = cc == 2 ? s1 : sb2; sb3 = cc == 3 ? s1 : sb3;
        }
        { typedef _Float16 h4 __attribute__((ext_vector_type(4)));
          h4 hv; hv[0] = (_Float16)sa0; hv[1] = (_Float16)sa1; hv[2] = (_Float16)sa2; hv[3] = (_Float16)sa3;
          *(h4*)(SC + (size_t)(32 * qt + 4 * c.wave + hk) * S + 128 * kt + 4 * r) = hv;
          hv[0] = (_Float16)sb0; hv[1] = (_Float16)sb1; hv[2] = (_Float16)sb2; hv[3] = (_Float16)sb3;
          *(h4*)(SC + (size_t)(32 * qt + 4 * c.wave + 2 + hk) * S + 128 * kt + 4 * r) = hv; }
        if (more) IDX_WRITE(cur ^ 1);
        qt = nqt; kt = nkt;
    }
#undef IDX_LOAD
#undef IDX_WRITE
    __syncthreads();
}

__device__ __forceinline__ unsigned f16key(unsigned h) { return (h & 0x8000u) ? (~h & 0xffffu) : (h | 0x8000u); }
__device__ __forceinline__ void hist_find(LAS unsigned* hist, int need, int lane, int& bsel, int& above) {
    LDS_WAIT();
    const u32x4 hv = *(const LAS u32x4*)(hist + 4 * (63 - lane));
    const int c0 = hv.w, c1 = hv.z, c2 = hv.y, c3 = hv.x, tot = c0 + c1 + c2 + c3;
    int inc = tot;
#pragma unroll
    for (int o = 1; o < 64; o <<= 1) { const int t = __shfl_up(inc, o); if (lane >= o) inc += t; }
    const int ex = inc - tot;
    const bool here = ex < need && inc >= need;
    int b = 0, ab = 0;
    if (here) { int cum = ex; if (cum + c0 >= need) { b = 255 - 4 * lane; ab = cum; } else { cum += c0; if (cum + c1 >= need) { b = 254 - 4 * lane; ab = cum; } else { cum += c1; if (cum + c2 >= need) { b = 253 - 4 * lane; ab = cum; } else { cum += c2; b = 252 - 4 * lane; ab = cum; } } } }
    const unsigned long long m = __ballot(here); const int src = m ? __builtin_ctzll(m) : 0;
    bsel = __shfl(b, src); above = __shfl(ab, src);
}
typedef short s16x4 __attribute__((ext_vector_type(4)));
__device__ __forceinline__ f32x4 mfma16(bf16x8 a_, bf16x8 b_, f32x4 c_) { return __builtin_amdgcn_mfma_f32_16x16x32_bf16(a_, b_, c_, 0, 0, 0); }
__device__ __forceinline__ void phase_dsa_attn(KA a, const Ctx& c) {
    unsigned char* ws = a.ws; const unsigned short* SC = (const unsigned short*)(ws + WU_SC); const bf16_t* CKVN = (const bf16_t*)(ws + WU_CKVN);
    const bf16_t* QLAT = (const bf16_t*)(ws + WU_QLAT); bf16_t* OLAT = (bf16_t*)(ws + WU_OLAT);
    LAS unsigned char* wl = c.lds + c.wave * 18432;
    LAS unsigned* hist = (LAS unsigned*)wl; LAS unsigned short* sel = (LAS unsigned short*)(wl + 1024); LAS unsigned char* kvl = wl + 2048;
    const int lane = c.lane, n16 = lane & 15, kq = lane >> 4;
    for (int t = c.gw; t < S; t += c.NGW) {
        const int nvalid = t + 1; int kk;
        if (nvalid <= 256) {
            kk = nvalid;
#pragma unroll
            for (int i = 0; i < 4; ++i) { const int k = lane + 64 * i; sel[k] = (unsigned short)(k < nvalid ? k : 0); }
        } else {
            kk = 256;
            const int lastc = t >> 3, nj = (t >> 9) + 1;
            unsigned zz = 0u; asm volatile("" : "+v"(zz));
            *(LAS u32x4*)(hist + 4 * lane) = (u32x4){zz, zz, zz, zz}; LDS_WAIT();
#pragma unroll 2
            for (int j = 0; j < nj; ++j) { const int ci = j * 64 + lane, cl = ci < lastc ? ci : lastc, s0 = ci * 8;
                u32x4 w = *(const u32x4*)(SC + (size_t)t * S + (size_t)cl * 8);
#pragma unroll
                for (int e = 0; e < 4; ++e) { unsigned k0 = f16key(w[e] & 0xffffu), k1 = f16key(w[e] >> 16);
                    k0 = (s0 + 2 * e > t) ? 0u : k0; k1 = (s0 + 2 * e + 1 > t) ? 0u : k1; w[e] = k0 | (k1 << 16);
                    __hip_atomic_fetch_add(hist + (k0 >> 8), 1u, __ATOMIC_RELAXED, __HIP_MEMORY_SCOPE_WORKGROUP);
                    __hip_atomic_fetch_add(hist + (k1 >> 8), 1u, __ATOMIC_RELAXED, __HIP_MEMORY_SCOPE_WORKGROUP); }
                *(LAS u32x4*)(kvl + ci * 16) = w; }
            int b1, above1; hist_find(hist, 256, lane, b1, above1);
            *(LAS u32x4*)(hist + 4 * lane) = (u32x4){zz, zz, zz, zz}; LDS_WAIT();
#pragma unroll 2
            for (int j = 0; j < nj; ++j) { const u32x4 w = *(const LAS u32x4*)(kvl + (j * 64 + lane) * 16);
#pragma unroll
                for (int e = 0; e < 4; ++e) {
                    if ((int)((w[e] >> 8) & 0xff) == b1) __hip_atomic_fetch_add(hist + (w[e] & 0xff), 1u, __ATOMIC_RELAXED, __HIP_MEMORY_SCOPE_WORKGROUP);
                    if ((int)(w[e] >> 24) == b1) __hip_atomic_fetch_add(hist + ((w[e] >> 16) & 0xff), 1u, __ATOMIC_RELAXED, __HIP_MEMORY_SCOPE_WORKGROUP); } }
            int b2, above2; hist_find(hist, 256 - above1, lane, b2, above2);
            const unsigned T = ((unsigned)b1 << 8) | (unsigned)b2; const int need_eq = 256 - above1 - above2;
            int cnt = 0, eqc = 0;
#pragma unroll 1
            for (int j = 0; j < nj; ++j) { const u32x4 w = *(const LAS u32x4*)(kvl + (j * 64 + lane) * 16);
#pragma unroll
                for (int e = 0; e < 8; ++e) { const unsigned k = (w[e >> 1] >> ((e & 1) * 16)) & 0xffffu;
                    const bool gt = k > T, eq = k == T;
                    const unsigned long long be = __ballot(eq);
                    const int eqrank = eqc + __builtin_amdgcn_mbcnt_hi((unsigned)(be >> 32), __builtin_amdgcn_mbcnt_lo((unsigned)be, 0));
                    const bool take = gt || (eq && eqrank < need_eq);
                    const unsigned long long bt = __ballot(take);
                    const int pos = cnt + __builtin_amdgcn_mbcnt_hi((unsigned)(bt >> 32), __builtin_amdgcn_mbcnt_lo((unsigned)bt, 0));
                    if (take) sel[pos] = (unsigned short)((j * 64 + lane) * 8 + e);
                    cnt += __builtin_popcountll(bt); eqc += __builtin_popcountll(be); } }
        }
        LDS_WAIT(); __builtin_amdgcn_sched_barrier(0);
        bf16x8 qf[8];
        { const bf16_t* qrow = QLAT + (size_t)t * 4096 + n16 * KVR + 8 * kq;
#pragma unroll
          for (int ks = 0; ks < 8; ++ks) qf[ks] = *(const bf16x8*)(qrow + 32 * ks); }
        f32x4 oacc[16];
#pragma unroll
        for (int ct = 0; ct < 16; ++ct) oacc[ct] = (f32x4){0.f, 0.f, 0.f, 0.f};
        float m_run = -1.0e30f, l_run = 0.f;
        const float slope = __builtin_amdgcn_exp2f(-0.5f * (float)(n16 + 1));
        const int nch = (kk + 31) >> 5;
        const int trq = n16 >> 2, trp = n16 & 3, trrow = 4 * kq + trq;
        for (int ch = 0; ch < nch; ++ch) {
#pragma unroll
            for (int hf = 0; hf < 2; ++hf) {
                u32x4 stg[8];
#pragma unroll
                for (int i = 0; i < 8; ++i) { const int row = 16 * hf + 2 * i + (lane >> 5), kidx = ch * 32 + row; const int sk = sel[kidx < kk ? kidx : 0];
                    stg[i] = *(const u32x4*)(CKVN + (size_t)sk * KVR + (lane & 31) * 8); }
#pragma unroll
                for (int i = 0; i < 8; ++i) { const int row = 16 * hf + 2 * i + (lane >> 5), cch = lane & 31;
                    *(LAS u32x4*)(kvl + row * 512 + (((cch & 16) | ((cch & 15) ^ (row & 15))) << 4)) = stg[i]; }
                __builtin_amdgcn_sched_barrier(0);
            }
            LDS_WAIT();
            f32x4 s0 = (f32x4){0.f, 0.f, 0.f, 0.f}, s1 = (f32x4){0.f, 0.f, 0.f, 0.f};
#pragma unroll
            for (int ks = 0; ks < 8; ++ks) { const int chunk = 4 * ks + kq, sw = ((chunk & 16) | ((chunk & 15) ^ n16)) << 4;
                const bf16x8 a0 = *(const LAS bf16x8*)(kvl + n16 * 512 + sw), a1 = *(const LAS bf16x8*)(kvl + (16 + n16) * 512 + sw);
                s0 = mfma16(a0, qf[ks], s0); s1 = mfma16(a1, qf[ks], s1); }
            float mx = -1.0e30f;
#pragma unroll
            for (int r = 0; r < 4; ++r) { const int k0 = ch * 32 + 4 * kq + r, k1 = k0 + 16;
                const int sk0 = sel[k0 < kk ? k0 : 0], sk1 = sel[k1 < kk ? k1 : 0];
                s0[r] = k0 < kk ? s0[r] - slope * (float)(t - sk0) : -1.0e30f; s1[r] = k1 < kk ? s1[r] - slope * (float)(t - sk1) : -1.0e30f;
                mx = fmaxf(mx, fmaxf(s0[r], s1[r])); }
            mx = fmaxf(mx, __shfl_xor(mx, 16)); mx = fmaxf(mx, __shfl_xor(mx, 32));
            const float m_new = fmaxf(m_run, mx), alpha = __builtin_amdgcn_exp2f((m_run - m_new) * LOG2E); m_run = m_new;
            float ps = 0.f;
#pragma unroll
            for (int r = 0; r < 4; ++r) { s0[r] = __builtin_amdgcn_exp2f((s0[r] - m_new) * LOG2E); s1[r] = __builtin_amdgcn_exp2f((s1[r] - m_new) * LOG2E); ps += s0[r] + s1[r]; }
            l_run = l_run * alpha + ps;
#pragma unroll
            for (int ct = 0; ct < 16; ++ct) oacc[ct] *= alpha;
            u32x4 pw; pw.x = cvt_pk_bf16(s0[0], s0[1]); pw.y = cvt_pk_bf16(s0[2], s0[3]); pw.z = cvt_pk_bf16(s1[0], s1[1]); pw.w = cvt_pk_bf16(s1[2], s1[3]);
            const bf16x8 pb = __builtin_bit_cast(bf16x8, pw);
#pragma unroll
            for (int ct = 0; ct < 16; ++ct) { const int chunk = 2 * ct + (trp >> 1), sw = (((chunk & 16) | ((chunk & 15) ^ (trrow & 15))) << 4) + 8 * (trp & 1);
                const s16x4 t0 = __builtin_amdgcn_ds_read_tr16_b64_v4i16((LAS s16x4*)(kvl + trrow * 512 + sw));
                const s16x4 t1 = __builtin_amdgcn_ds_read_tr16_b64_v4i16((LAS s16x4*)(kvl + (16 + trrow) * 512 + sw));
                const bf16x8 a2 = (bf16x8){t0[0], t0[1], t0[2], t0[3], t1[0], t1[1], t1[2], t1[3]};
                oacc[ct] = mfma16(a2, pb, oacc[ct]); }
            LDS_WAIT();
        }
        float lt = l_run; lt += __shfl_xor(lt, 16); lt += __shfl_xor(lt, 32);
        const float inv = 1.0f / lt;
#pragma unroll
        for (int ct = 0; ct < 16; ++ct) { const f32x4 o = oacc[ct] * inv; u32x2 w; w.x = cvt_pk_bf16(o[0], o[1]); w.y = cvt_pk_bf16(o[2], o[3]);
            *(u32x2*)(OLAT + (size_t)t * 4096 + n16 * KVR + 16 * ct + 4 * kq) = w; }
    }
}


__device__ __forceinline__ void phase_moba_gate(KA a, const Ctx& c, int j) {
    unsigned char* ws = a.ws; const bf16_t* Q = (const bf16_t*)(ws + WU_Q); const float* KMEAN = (const float*)(ws + WS_KMEAN) + (size_t)j * NH * 32 * HD;
    int* CNT = (int*)(ws + WS_CNT) + j * NH * 32; unsigned short* LIST = (unsigned short*)(ws + WU_LIST);
    LAS float* km = (LAS float*)c.lds;
    const int lane = c.lane;
    for (int it0 = c.vcu * 8; it0 < 2048; it0 += c.G * 8) {
        const int h = it0 >> 7;
        __syncthreads();
        for (int i = c.tid; i < 32 * 128 / 4; i += 512) *(LAS f32x4*)(km + 4 * i) = *(const f32x4*)(KMEAN + (size_t)h * 32 * HD + 4 * i);
        __syncthreads();
        const int g = (it0 & 127) + c.wave, t = 64 * g + lane, own = g >> 2;
        float qf[128];
        { const u32x4* qp4 = (const u32x4*)(Q + (size_t)t * D + h * HD);
#pragma unroll
          for (int i = 0; i < 16; ++i) { const u32x4 v = qp4[i]; qf[8 * i] = bf_lo(v.x); qf[8 * i + 1] = bf_hi(v.x); qf[8 * i + 2] = bf_lo(v.y); qf[8 * i + 3] = bf_hi(v.y);
              qf[8 * i + 4] = bf_lo(v.z); qf[8 * i + 5] = bf_hi(v.z); qf[8 * i + 6] = bf_lo(v.w); qf[8 * i + 7] = bf_hi(v.w); } }
        float v0 = -3.0e38f, v1 = -3.0e38f, v2 = -3.0e38f; int i0 = -1, i1 = -1, i2 = -1;
#pragma unroll 1
        for (int n = 0; n < own; ++n) { float s0 = 0.f, s1 = 0.f, s2 = 0.f, s3 = 0.f;
#pragma unroll
            for (int i = 0; i < 32; ++i) { const f32x4 kv = *(const LAS f32x4*)(km + n * 128 + 4 * i); s0 += qf[4 * i] * kv[0]; s1 += qf[4 * i + 1] * kv[1]; s2 += qf[4 * i + 2] * kv[2]; s3 += qf[4 * i + 3] * kv[3]; }
            const float gv = (s0 + s1) + (s2 + s3);
            if (gv > v0) { v2 = v1; i2 = i1; v1 = v0; i1 = i0; v0 = gv; i0 = n; } else if (gv > v1) { v2 = v1; i2 = i1; v1 = gv; i1 = n; } else if (gv > v2) { v2 = gv; i2 = n; } }
#pragma unroll 1
        for (int n = 0; n < own; ++n) { const int rk = (i0 == n) ? 0 : ((i1 == n) ? 1 : ((i2 == n) ? 2 : -1));
            const unsigned long long m = __ballot(rk >= 0);
            if (m) { int base = 0; const int first = __builtin_ctzll(m);
                if (lane == first) base = atomicAdd(CNT + h * 32 + n, (int)__builtin_popcountll(m));
                base = __shfl(base, first);
                const int pos = base + __builtin_amdgcn_mbcnt_hi((unsigned)(m >> 32), __builtin_amdgcn_mbcnt_lo((unsigned)m, 0));
                if (rk >= 0) LIST[((size_t)h * 32 + n) * 8192 + pos] = (unsigned short)(t | (rk << 13)); } }
    }
    __syncthreads();
}

namespace mat {
constexpr int KVBLK = 64, QBLK = 32;
constexpr float C2 = QK_SCALE * LOG2E;
constexpr float THR = 8.f;
constexpr size_t SHM_V = KVBLK * HD * 2, SHM_K = KVBLK * HD * 2;
constexpr int OFF_V = 0, OFF_K = 2 * SHM_V, OFF_WS = OFF_K + 2 * SHM_K  , OFF_TQ = OFF_WS + 8 * 256  , OFF_PFX = OFF_TQ + 8 * 128  ,
              OFF_OST = 70 * 1024  , LDS_END = OFF_OST + 8 * 8192;
static_assert(OFF_PFX + 516 * 4 <= OFF_OST && LDS_END <= LDS_BYTES, "moba attention LDS map");
typedef short s16x4 __attribute__((ext_vector_type(4)));
#define KSWZ(row, colB) ((row) * 256 + ((colB) ^ (((row) & 7) << 4)))
#define SBAR() __builtin_amdgcn_sched_barrier(0)
__device__ __forceinline__ int crow(int r, int hi) { return (r & 3) + 8 * (r >> 2) + 4 * hi; }
__device__ __forceinline__ void partialSM(f32x16& p0, f32x16& p1, float& m_reg, float& mn, float& alpha) {
  float pmax = p0[0];
#pragma unroll
  for (int r = 1; r < 16; ++r) pmax = fmaxf(pmax, p0[r]);
#pragma unroll
  for (int r = 0; r < 16; ++r) pmax = fmaxf(pmax, p1[r]);
  { auto rr = __builtin_amdgcn_permlane32_swap(__float_as_uint(pmax), __float_as_uint(pmax), false, false);
    pmax = fmaxf(__uint_as_float(rr[0]), __uint_as_float(rr[1])); }
  if (__builtin_expect(__all(pmax - m_reg <= THR / QK_SCALE), 1)) { mn = m_reg; alpha = 1.f; }
  else { mn = fmaxf(m_reg, pmax); alpha = __builtin_amdgcn_exp2f((m_reg - mn) * C2); m_reg = mn; }
  const float mnC = -mn * C2;
#pragma unroll
  for (int r = 0; r < 16; ++r) p0[r] = fmaf(p0[r], C2, mnC);
#pragma unroll
  for (int r = 0; r < 16; ++r) p1[r] = fmaf(p1[r], C2, mnC);
#pragma unroll
  for (int r = 0; r < 16; ++r) p0[r] = __builtin_amdgcn_exp2f(p0[r]);
}
__device__ __forceinline__ void finishSM(f32x16& p0, f32x16& p1, float alpha, float& l_reg, bf16x8& pa0, bf16x8& pa1, bf16x8& pa2, bf16x8& pa3) {
#pragma unroll
  for (int r = 0; r < 16; ++r) p1[r] = __builtin_amdgcn_exp2f(p1[r]);
  float ps = 0;
#pragma unroll
  for (int r = 0; r < 16; ++r) ps += p0[r];
#pragma unroll
  for (int r = 0; r < 16; ++r) ps += p1[r];
  { auto rr = __builtin_amdgcn_permlane32_swap(__float_as_uint(ps), __float_as_uint(ps), false, false);
    ps = __uint_as_float(rr[0]) + __uint_as_float(rr[1]); }
  l_reg = l_reg * alpha + ps;
#define PK4(P, BASE, OUT) do { unsigned a0 = cvt_pk_bf16(P[BASE + 0], P[BASE + 1]), a1 = cvt_pk_bf16(P[BASE + 2], P[BASE + 3]);   \
    unsigned b0 = cvt_pk_bf16(P[BASE + 4], P[BASE + 5]), b1 = cvt_pk_bf16(P[BASE + 6], P[BASE + 7]);                              \
    auto r0 = __builtin_amdgcn_permlane32_swap(a0, b0, false, false); auto r1 = __builtin_amdgcn_permlane32_swap(a1, b1, false, false); \
    u32x4 w = {r0[0], r1[0], r0[1], r1[1]}; OUT = __builtin_bit_cast(bf16x8, w); } while (0)
  PK4(p0, 0, pa0); PK4(p0, 8, pa1); PK4(p1, 0, pa2); PK4(p1, 8, pa3);
#undef PK4
}
template <bool CAUSAL>
__device__ __forceinline__ void qkt(f32x16& p0, f32x16& p1, const LAS unsigned char* Ks, const bf16x8* qr, int r32, int hi, float b0, float bs, int kpos0, int tq) {
#pragma unroll
  for (int r = 0; r < 16; ++r) { const float bb = b0 + bs * (float)((r & 3) + 8 * (r >> 2)); p0[r] = bb; p1[r] = bb + 32.f * bs; }
#pragma unroll
  for (int d0 = 0; d0 < 8; ++d0) { const int cb = (d0 * 16 + hi * 8) * 2;
    const bf16x8 k0 = *(const LAS bf16x8*)(Ks + KSWZ(r32, cb));
    const bf16x8 k1 = *(const LAS bf16x8*)(Ks + KSWZ(32 + r32, cb));
    p0 = __builtin_amdgcn_mfma_f32_32x32x16_bf16(k0, qr[d0], p0, 0, 0, 0);
    p1 = __builtin_amdgcn_mfma_f32_32x32x16_bf16(k1, qr[d0], p1, 0, 0, 0); }
  if (CAUSAL) {
#pragma unroll
    for (int r = 0; r < 16; ++r) { const int kp = kpos0 + (r & 3) + 8 * (r >> 2); p0[r] = kp > tq ? -1.0e30f : p0[r]; p1[r] = kp + 32 > tq ? -1.0e30f : p1[r]; }
  }
}
__device__ __forceinline__ int v_st(int k, int c) { const int kk = (k & ~0xC) | ((k & 4) << 1) | ((k & 8) >> 1); return ((kk >> 3) * 4 + (c >> 5)) * 512 + ((kk & 7) * 32 + (c & 31)) * 2; }
__device__ __forceinline__ int v_rd_base(int lane) { return ((lane & 3) << 3) | (((lane >> 2) & 3) << 6) | (((lane >> 4) & 1) << 5) | (((lane >> 5) & 1) << 8); }
constexpr int v_rd_off(int d0, int ks, int half) { return d0 * 512 + ks * 4096 + half * 2048; }
template <int D0> __device__ __forceinline__ void pv_one(f32x16& od, const LAS unsigned char* vb, bf16x8 pa0, bf16x8 pa1, bf16x8 pa2, bf16x8 pa3) {
#define TR(OFF) __builtin_amdgcn_ds_read_tr16_b64_v4i16((LAS s16x4*)(vb + (OFF)))
  const s16x4 l0 = TR(v_rd_off(D0, 0, 0)), h0 = TR(v_rd_off(D0, 0, 1)), l1 = TR(v_rd_off(D0, 1, 0)), h1 = TR(v_rd_off(D0, 1, 1));
  const s16x4 l2 = TR(v_rd_off(D0, 2, 0)), h2 = TR(v_rd_off(D0, 2, 1)), l3 = TR(v_rd_off(D0, 3, 0)), h3 = TR(v_rd_off(D0, 3, 1));
#undef TR
#define PK(L, H) (bf16x8){L[0], L[1], L[2], L[3], H[0], H[1], H[2], H[3]}
  od = __builtin_amdgcn_mfma_f32_32x32x16_bf16(pa0, PK(l0, h0), od, 0, 0, 0);
  od = __builtin_amdgcn_mfma_f32_32x32x16_bf16(pa1, PK(l1, h1), od, 0, 0, 0);
  od = __builtin_amdgcn_mfma_f32_32x32x16_bf16(pa2, PK(l2, h2), od, 0, 0, 0);
  od = __builtin_amdgcn_mfma_f32_32x32x16_bf16(pa3, PK(l3, h3), od, 0, 0, 0);
#undef PK
}
__device__ __forceinline__ void pv_d0(f32x16* o, const LAS unsigned char* vb, bf16x8 pa0, bf16x8 pa1, bf16x8 pa2, bf16x8 pa3) {
  pv_one<0>(o[0], vb, pa0, pa1, pa2, pa3); pv_one<1>(o[1], vb, pa0, pa1, pa2, pa3); pv_one<2>(o[2], vb, pa0, pa1, pa2, pa3); pv_one<3>(o[3], vb, pa0, pa1, pa2, pa3);
}

template <bool CAUSAL>
__device__ __forceinline__ void item_body(const bf16_t* __restrict__ Q, const bf16_t* __restrict__ Kh, const bf16_t* __restrict__ Vh, bf16_t* __restrict__ OPART, float* __restrict__ ML,
                                          int h, int n, unsigned ent, LAS unsigned char* lds, int tid) {
  const int wid = tid >> 6, lane = tid & 63, r32 = lane & 31, hi = lane >> 5;
  LAS unsigned char* V_lds = lds + OFF_V; LAS unsigned char* K_lds = lds + OFF_K;
  LAS float* wsf = (LAS float*)(lds + OFF_WS) + wid * 64; LAS float* li_l = wsf; LAS float* al_l = wsf + 32;
  LAS unsigned* tq_l = (LAS unsigned*)(lds + OFF_TQ) + wid * 32;
  const int tq = (int)(ent & 8191u);
  float m_reg = -1e30f, l_reg = 0; f32x16 o[4] = {}; bf16x8 qr[8];
  { const bf16_t* Qw = Q + (size_t)tq * D + h * HD + hi * 8;
#pragma unroll
    for (int d0 = 0; d0 < 8; ++d0) qr[d0] = *(const bf16x8*)(Qw + d0 * 16); }
  const float bs = __builtin_amdgcn_exp2f(-0.5f * (float)(h + 1)) * (1.0f / QK_SCALE);
  const int kp0 = n * 256 + 4 * hi;
  const float bq = bs * (float)(kp0 - tq);
  const int sr = tid >> 4, sc = (tid & 15) * 8, vst0 = v_st(sr, sc), vst1 = v_st(32 + sr, sc);
  const LAS unsigned char* vb0 = V_lds + v_rd_base(lane);
  bf16x8 vs0, vs1, ks0, ks1;
#define SLOAD(k0) do { vs0 = *(const bf16x8*)(Vh + (size_t)((k0) + sr) * D + sc); vs1 = *(const bf16x8*)(Vh + (size_t)((k0) + 32 + sr) * D + sc); \
    ks0 = *(const bf16x8*)(Kh + (size_t)((k0) + sr) * D + sc); ks1 = *(const bf16x8*)(Kh + (size_t)((k0) + 32 + sr) * D + sc); } while (0)
#define SWRITE(b) do { *(LAS bf16x8*)(V_lds + (b) * SHM_V + vst0) = vs0; *(LAS bf16x8*)(V_lds + (b) * SHM_V + vst1) = vs1; const int kc = sc * 2; \
    *(LAS bf16x8*)(K_lds + (b) * SHM_K + KSWZ(sr, kc)) = ks0; *(LAS bf16x8*)(K_lds + (b) * SHM_K + KSWZ(32 + sr, kc)) = ks1; } while (0)
#define SWAIT() asm volatile("s_waitcnt vmcnt(0)" ::: "memory")
#define RESC(al) do { if (__any((al) < 1.f)) { if (hi == 0) al_l[r32] = (al); asm volatile("s_waitcnt lgkmcnt(0)" ::: "memory"); \
    _Pragma("unroll") for (int d = 0; d < 4; ++d) _Pragma("unroll") for (int r = 0; r < 16; ++r) o[d][r] *= al_l[crow(r, hi)]; } } while (0)
  f32x16 pA0, pA1, pB0, pB1; float mnA, mnB, alA, alB; bf16x8 pa0, pa1, pa2, pa3;
  SLOAD(0); SWAIT(); SWRITE(0); __syncthreads();
  qkt<CAUSAL>(pA0, pA1, K_lds, qr, r32, hi, bq, bs, kp0, tq); partialSM(pA0, pA1, m_reg, mnA, alA);
  SLOAD(KVBLK); SWAIT(); SWRITE(1); __syncthreads();
  {
    SBAR(); qkt<CAUSAL>(pB0, pB1, K_lds + SHM_K, qr, r32, hi, bq + 64.f * bs, bs, kp0 + 64, tq);
    finishSM(pA0, pA1, alA, l_reg, pa0, pa1, pa2, pa3); SBAR();
    SLOAD(2 * KVBLK); SBAR();
    pv_d0(o, vb0, pa0, pa1, pa2, pa3); partialSM(pB0, pB1, m_reg, mnB, alB);
    __syncthreads(); SWAIT(); SWRITE(0);
    RESC(alB); __syncthreads();
    SBAR(); qkt<CAUSAL>(pA0, pA1, K_lds, qr, r32, hi, bq + 128.f * bs, bs, kp0 + 128, tq);
    finishSM(pB0, pB1, alB, l_reg, pa0, pa1, pa2, pa3); SBAR();
    SLOAD(3 * KVBLK); SBAR();
    pv_d0(o, vb0 + SHM_V, pa0, pa1, pa2, pa3); partialSM(pA0, pA1, m_reg, mnA, alA);
    __syncthreads(); SWAIT(); SWRITE(1);
    RESC(alA); __syncthreads();
  }
  SBAR(); qkt<CAUSAL>(pB0, pB1, K_lds + SHM_K, qr, r32, hi, bq + 192.f * bs, bs, kp0 + 192, tq);
  finishSM(pA0, pA1, alA, l_reg, pa0, pa1, pa2, pa3); SBAR();
  pv_d0(o, vb0, pa0, pa1, pa2, pa3); partialSM(pB0, pB1, m_reg, mnB, alB);
  __syncthreads(); RESC(alB);
  finishSM(pB0, pB1, alB, l_reg, pa0, pa1, pa2, pa3); SBAR();
  pv_d0(o, vb0 + SHM_V, pa0, pa1, pa2, pa3);
  if (hi == 0) { li_l[r32] = l_reg; tq_l[r32] = ent; }
  asm volatile("s_waitcnt lgkmcnt(0)" ::: "memory");
  LAS unsigned short* ost = (LAS unsigned short*)(lds + OFF_OST + wid * 8192);
#pragma unroll
  for (int r = 0; r < 16; ++r) { const int orow = crow(r, hi); const float rl = __builtin_amdgcn_rcpf(li_l[orow]);
#pragma unroll
    for (int d0 = 0; d0 < 4; ++d0) ost[orow * 128 + d0 * 32 + r32] = (unsigned short)f2bf(o[d0][r] * rl); }
  asm volatile("s_waitcnt lgkmcnt(0)" ::: "memory");
#pragma unroll
  for (int i = 0; i < 8; ++i) { const int row = 4 * i + (lane >> 4), ch = lane & 15; const unsigned e = tq_l[row];
    const u32x4 v = *(const LAS u32x4*)((LAS unsigned char*)ost + row * 256 + ch * 16);
    if (!(e & 0x8000u)) *(u32x4*)(OPART + ((size_t)((e >> 13) & 3u) * S + (e & 8191u)) * D + h * HD + ch * 8) = v; }
  if (hi == 0 && !(ent & 0x8000u)) { float* p = ML + (((size_t)((ent >> 13) & 3u) * S + tq) * NH + h) * 2; p[0] = m_reg * C2; p[1] = l_reg; }
  __syncthreads();
#undef SLOAD
#undef SWRITE
#undef SWAIT
#undef RESC
}
#undef KSWZ
#undef SBAR
}

__device__ __forceinline__ void phase_moba_attn(KA a, const Ctx& c, int j) {
    unsigned char* ws = a.ws; const bf16_t* Q = (const bf16_t*)(ws + WU_Q); const bf16_t* Kb = (const bf16_t*)(ws + WU_K); const bf16_t* V = (const bf16_t*)(ws + WU_V);
    bf16_t* OPART = (bf16_t*)(ws + WU_OPART); float* ML = (float*)(ws + WU_ML); const int* CNT = (const int*)(ws + WS_CNT) + j * NH * 32; const unsigned short* LIST = (const unsigned short*)(ws + WU_LIST);
    LAS int* pfx = (LAS int*)(c.lds + mat::OFF_PFX);
    if (c.tid == 0) { int run = 0; for (int i = 0; i < 512; ++i) { pfx[i] = run; run += 1 + ((CNT[i] + 255) >> 8); } pfx[512] = run; }
    __syncthreads();
    const int total = __builtin_amdgcn_readfirstlane(pfx[512]);
    for (int it = c.vcu; it < total; it += c.G) {
        int lo = 0, hi_ = 511;
        while (lo < hi_) { const int mid = (lo + hi_ + 1) >> 1; if (pfx[mid] <= it) lo = mid; else hi_ = mid - 1; }
        const int pair = lo, h = pair >> 5, n = pair & 31, tile = it - pfx[pair];
        const bf16_t* Kh = Kb + (size_t)(n * 256) * D + h * HD; const bf16_t* Vh = V + (size_t)(n * 256) * D + h * HD;
        int tidl = c.tid; asm volatile("" : "+v"(tidl));
        const int e = ((tidl >> 6) << 5) + (tidl & 31);
        if (tile == 0) { const unsigned ent = (unsigned)(n * 256 + e) | (3u << 13);
            mat::item_body<true>(Q, Kh, Vh, OPART, ML, h, n, ent, c.lds, tidl);
        } else { const int cnt = CNT[pair], idx = (tile - 1) * 256 + e; unsigned ent = LIST[(size_t)pair * 8192 + (idx < cnt ? idx : 0)]; if (idx >= cnt) ent |= 0x8000u;
            mat::item_body<false>(Q, Kh, Vh, OPART, ML, h, n, ent, c.lds, tidl); }
    }
    __syncthreads();
}

__device__ __forceinline__ void phase_moba_combine(KA a, const Ctx& c) {
    unsigned char* ws = a.ws; const bf16_t* OPART = (const bf16_t*)(ws + WU_OPART); const float* ML = (const float*)(ws + WU_ML);
    const bf16_t* SG = (const bf16_t*)(ws + WS_SG); bf16_t* GACT = (bf16_t*)(ws + WS_GACT);
    const int lane = c.lane;
    for (int it = c.gw; it < S * 4; it += c.NGW) {
        const int t = it >> 2, h = (it & 3) * 4 + (lane >> 4), dq = lane & 15, own = t >> 8, np = own < 3 ? own : 3;
        float m[4], l[4]; float M = -3.0e38f;
#pragma unroll
        for (int sl = 0; sl < 4; ++sl) { const bool ok = sl == 3 || sl < np; const float* p = ML + (((size_t)sl * S + t) * NH + h) * 2; m[sl] = ok ? p[0] : -3.0e38f; l[sl] = ok ? p[1] : 0.f; M = fmaxf(M, m[sl]); }
        float wsum = 0.f; float o[8];
#pragma unroll
        for (int e = 0; e < 8; ++e) o[e] = 0.f;
#pragma unroll
        for (int sl = 0; sl < 4; ++sl) { const bool ok = sl == 3 || sl < np; const float w = ok ? l[sl] * __builtin_amdgcn_exp2f(m[sl] - M) : 0.f; wsum += w;
            u32x4 v = (u32x4){0u, 0u, 0u, 0u}; if (ok) v = *(const u32x4*)(OPART + ((size_t)sl * S + t) * D + h * HD + dq * 8);
            o[0] += w * bf_lo(v.x); o[1] += w * bf_hi(v.x); o[2] += w * bf_lo(v.y); o[3] += w * bf_hi(v.y); o[4] += w * bf_lo(v.z); o[5] += w * bf_hi(v.z); o[6] += w * bf_lo(v.w); o[7] += w * bf_hi(v.w); }
        const float inv = 1.0f / wsum; const size_t off = (size_t)t * D + h * HD + dq * 8; const u32x4 gv = *(const u32x4*)(SG + off);
        u32x4 w; w.x = pk2(o[0] * inv * bf_lo(gv.x), o[1] * inv * bf_hi(gv.x)); w.y = pk2(o[2] * inv * bf_lo(gv.y), o[3] * inv * bf_hi(gv.y));
        w.z = pk2(o[4] * inv * bf_lo(gv.z), o[5] * inv * bf_hi(gv.z)); w.w = pk2(o[6] * inv * bf_lo(gv.w), o[7] * inv * bf_hi(gv.w));
        *(u32x4*)(GACT + off) = w;
    }
}

__device__ __forceinline__ float bfu(bf16_t v) { return __builtin_bit_cast(float, (unsigned)v << 16); }
struct ChkAcc { LAS float* ss; LAS unsigned* mx; LAS unsigned* cnt; };
__device__ __forceinline__ void chk_add(const ChkAcc& A, float naive, float mine) {
    atomicAdd((float*)A.ss, naive * naive); atomicMax((unsigned*)A.mx, __builtin_bit_cast(unsigned, fabsf(naive - mine))); atomicAdd((unsigned*)A.cnt, 1u);
}
__device__ __forceinline__ void chk_begin(const ChkAcc& A, int tid) { __syncthreads(); if (tid == 0) { *A.ss = 0.f; *A.mx = 0u; *A.cnt = 0u; } __syncthreads(); }
__device__ __forceinline__ void chk_end(const ChkAcc& A, int tid, float* dbg, int stage) {
    __syncthreads();
    if (tid == 0) { const float rms = sqrtf(*A.ss / fmaxf((float)*A.cnt, 1.f)) + 1e-20f; const float e = __builtin_bit_cast(float, *A.mx) / rms;
        atomicMax((unsigned*)(dbg + stage), __builtin_bit_cast(unsigned, e)); }
    __syncthreads();
}
__device__ __forceinline__ unsigned f16key_d(unsigned h) { return (h & 0x8000u) ? (~h & 0xffffu) : (h | 0x8000u); }

__device__ __forceinline__ void check_dsa(KA a, unsigned char* ws, LAS unsigned char* lds, int tid, int layer) {
    const int j = layer >> 1; float* dbg = (float*)(ws + WS_CTL + 4096) + layer * 16;
    ChkAcc A{(LAS float*)(lds + 0), (LAS unsigned*)(lds + 4), (LAS unsigned*)(lds + 8)};
    LAS float* buf = (LAS float*)(lds + 1024);
    LAS unsigned short* keys = (LAS unsigned short*)(lds + 1024 + 32768);
    LAS int* slist = (LAS int*)(lds + 1024 + 32768 + 16384);
    LAS float* lgt = (LAS float*)(lds + 1024 + 32768 + 16384 + 2048);
    const bf16_t* HB = (const bf16_t*)(ws + WS_HB); const bf16_t* CQ = (const bf16_t*)(ws + WU_CQ); const float* CKV = (const float*)(ws + WU_CKV);
    const bf16_t* CKVN = (const bf16_t*)(ws + WU_CKVN); const bf16_t* KIDX = (const bf16_t*)(ws + WU_KIDX); const float* WIDX = (const float*)(ws + WS_WIDX);
    const bf16_t* SG = (const bf16_t*)(ws + WS_SG); const bf16_t* QLAT = (const bf16_t*)(ws + WU_QLAT); const bf16_t* QIDX = (const bf16_t*)(ws + WU_QIDX);
    const unsigned short* SC = (const unsigned short*)(ws + WU_SC); const bf16_t* OLAT = (const bf16_t*)(ws + WU_OLAT); const bf16_t* GACT = (const bf16_t*)(ws + WS_GACT);
    const float* Z = (const float*)(ws + WS_Z); const float* MOD = (const float*)(ws + WS_MOD);
    const float* w_in = a.in[6] + (size_t)j * D * DSA_IN; const float* g_q = a.in[7] + j * QR; const float* g_kv = a.in[8] + j * KVR;
    const float* w_uq = a.in[9] + (size_t)j * QR * 2048; const float* w_qi = a.in[10] + (size_t)j * QR * 2048; const float* w_uk = a.in[11] + (size_t)j * NH * HD * KVR;
    const float* w_uv = a.in[12] + (size_t)j * NH * KVR * HD; const float* w_o = a.in[13] + (size_t)j * D * D;
    const float* X = layer == 0 ? a.in[0] : (const float*)(ws + WS_X1);
    for (int ti = 0; ti < 32; ++ti) {
        const int t = (int)(blockIdx.x + 256u * ti);
        chk_begin(A, tid);
        for (int n = tid; n < DSA_IN; n += 512) { float s = 0.f; for (int k = 0; k < D; ++k) s += bfu(HB[(size_t)t * D + k]) * w_in[(size_t)k * DSA_IN + n];
            float mine;
            if (n < 512) mine = bfu(CQ[(size_t)t * QR + n]); else if (n < 768) mine = CKV[(size_t)t * KVR + n - 512]; else if (n < 896) mine = bfu(KIDX[(size_t)t * 128 + n - 768]);
            else if (n < 912) { mine = WIDX[(size_t)t * 16 + n - 896]; s *= 0.25f; } else { mine = bfu(SG[(size_t)t * D + n - 912]); s = s / (1.f + expf(-s)); }
            chk_add(A, s, mine); }
        chk_end(A, tid, dbg, 1);
        chk_begin(A, tid);
        { float ss = 0.f; for (int k = 0; k < KVR; ++k) { const float v = CKV[(size_t)t * KVR + k]; ss += v * v; } const float rs = 1.f / sqrtf(ss / KVR + LN_EPS);
          for (int n = tid; n < KVR; n += 512) chk_add(A, CKV[(size_t)t * KVR + n] * rs * g_kv[n], bfu(CKVN[(size_t)t * KVR + n])); }
        chk_end(A, tid, dbg, 1);
        { float ss = 0.f; for (int k = 0; k < QR; ++k) { const float v = bfu(CQ[(size_t)t * QR + k]); ss += v * v; } const float rs = 1.f / sqrtf(ss / QR + LN_EPS);
          __syncthreads();
          for (int k = tid; k < QR; k += 512) buf[k] = bfu(CQ[(size_t)t * QR + k]) * rs * g_q[k];
          __syncthreads();
          for (int n = tid; n < 2048; n += 512) { float s = 0.f; for (int k = 0; k < QR; ++k) s += buf[k] * w_uq[(size_t)k * 2048 + n]; buf[1024 + n] = s; }
          chk_begin(A, tid);
          for (int n = tid; n < 4096; n += 512) { const int h = n >> 8, cc = n & 255; float s = 0.f; for (int d = 0; d < HD; ++d) s += buf[1024 + h * HD + d] * w_uk[((size_t)h * HD + d) * KVR + cc];
              chk_add(A, s * QK_SCALE, bfu(QLAT[(size_t)t * 4096 + n])); }
          chk_end(A, tid, dbg, 2);
          chk_begin(A, tid);
          for (int n = tid; n < 2048; n += 512) { float s = 0.f; for (int k = 0; k < QR; ++k) s += buf[k] * w_qi[(size_t)k * 2048 + n]; chk_add(A, s * QK_SCALE, bfu(QIDX[(size_t)t * 2048 + n])); }
          chk_end(A, tid, dbg, 2); }
        chk_begin(A, tid);
        for (int sidx = tid; sidx <= t; sidx += 512) { float sc = 0.f;
            for (int h = 0; h < 16; ++h) { float l = 0.f; for (int d = 0; d < 128; ++d) l += bfu(QIDX[(size_t)t * 2048 + h * 128 + d]) * bfu(KIDX[(size_t)sidx * 128 + d]); sc += WIDX[(size_t)t * 16 + h] * fmaxf(l, 0.f); }
            const unsigned short hb = SC[(size_t)t * S + sidx]; _Float16 hv = __builtin_bit_cast(_Float16, hb); chk_add(A, sc, (float)hv); }
        chk_end(A, tid, dbg, 3);
        __syncthreads();
        for (int sidx = tid; sidx < S; sidx += 512) keys[sidx] = sidx <= t ? (unsigned short)f16key_d(SC[(size_t)t * S + sidx]) : (unsigned short)0;
        if (tid == 0) slist[256] = 0;
        __syncthreads();
        const int kk = t + 1 < 256 ? t + 1 : 256;
        for (int sidx = tid; sidx <= t; sidx += 512) {
            bool selq;
            if (t + 1 <= 256) selq = true;
            else { const unsigned k0 = keys[sidx]; const int o0 = (sidx >> 9) * 512 + (sidx & 7) * 64 + ((sidx >> 3) & 63); int rank = 0;
                for (int s2 = 0; s2 <= t; ++s2) { const unsigned k2 = keys[s2]; const int o2 = (s2 >> 9) * 512 + (s2 & 7) * 64 + ((s2 >> 3) & 63); rank += (k2 > k0 || (k2 == k0 && o2 < o0)) ? 1 : 0; }
                selq = rank < 256; }
            if (selq) { const int p = atomicAdd((int*)&slist[256], 1); if (p < 256) slist[p] = sidx; } }
        __syncthreads();
        for (int idx = tid; idx < 16 * 256; idx += 512) { const int h = idx >> 8, k = idx & 255; float l = -1e30f;
            if (k < kk) { const int sk = slist[k]; float s = 0.f; for (int cc = 0; cc < KVR; ++cc) s += bfu(QLAT[(size_t)t * 4096 + h * KVR + cc]) * bfu(CKVN[(size_t)sk * KVR + cc]);
                l = s - exp2f(-0.5f * (float)(h + 1)) * (float)(t - sk); }
            lgt[idx] = l; }
        __syncthreads();
        if (tid < 16) { float m = -1e30f; for (int k = 0; k < 256; ++k) m = fmaxf(m, lgt[tid * 256 + k]); float sum = 0.f; for (int k = 0; k < 256; ++k) { const float e = lgt[tid * 256 + k] > -1e29f ? expf(lgt[tid * 256 + k] - m) : 0.f; lgt[tid * 256 + k] = e; sum += e; }
            for (int k = 0; k < 256; ++k) lgt[tid * 256 + k] /= sum; }
        chk_begin(A, tid);
        for (int n = tid; n < 4096; n += 512) { const int h = n >> 8, cc = n & 255; float s = 0.f; for (int k = 0; k < kk; ++k) s += lgt[h * 256 + k] * bfu(CKVN[(size_t)slist[k] * KVR + cc]);
            chk_add(A, s, bfu(OLAT[(size_t)t * 4096 + n])); }
        chk_end(A, tid, dbg, 5);
        chk_begin(A, tid);
        for (int n = tid; n < D; n += 512) { const int h = n >> 7, d = n & 127; float s = 0.f; for (int cc = 0; cc < KVR; ++cc) s += bfu(OLAT[(size_t)t * 4096 + h * KVR + cc]) * w_uv[((size_t)h * KVR + cc) * HD + d];
            chk_add(A, s * bfu(SG[(size_t)t * D + n]), bfu(GACT[(size_t)t * D + n])); }
        chk_end(A, tid, dbg, 6);
        chk_begin(A, tid);
        for (int n = tid; n < D; n += 512) { float s = 0.f; for (int k = 0; k < D; ++k) s += bfu(GACT[(size_t)t * D + k]) * w_o[(size_t)k * D + n];
            chk_add(A, DN_ALPHA * X[(size_t)t * D + n] + MOD[(size_t)layer * 6144 + 4096 + n] * s, Z[(size_t)t * D + n]); }
        chk_end(A, tid, dbg, 7);
    }
}
__device__ __forceinline__ void check_moba(KA a, unsigned char* ws, LAS unsigned char* lds, int tid, int layer) {
    const int j = layer >> 1; float* dbg = (float*)(ws + WS_CTL + 4096) + layer * 16;
    ChkAcc A{(LAS float*)(lds + 0), (LAS unsigned*)(lds + 4), (LAS unsigned*)(lds + 8)};
    LAS float* pbuf = (LAS float*)(lds + 1024);
    LAS int* blks = (LAS int*)(lds + 1024 + 65536);
    const bf16_t* HB = (const bf16_t*)(ws + WS_HB); const bf16_t* Q = (const bf16_t*)(ws + WU_Q); const bf16_t* Kb = (const bf16_t*)(ws + WU_K); const bf16_t* V = (const bf16_t*)(ws + WU_V);
    const bf16_t* SG = (const bf16_t*)(ws + WS_SG); const bf16_t* GACT = (const bf16_t*)(ws + WS_GACT); const float* KMEAN = (const float*)(ws + WS_KMEAN) + (size_t)j * NH * 32 * HD;
    const float* Z = (const float*)(ws + WS_Z); const float* MOD = (const float*)(ws + WS_MOD); const float* X = (const float*)(ws + WS_X1);
    const float* w_in = a.in[14] + (size_t)j * D * MOBA_IN; const float* w_o = a.in[15] + (size_t)j * D * D;
    chk_begin(A, tid);
    for (int idx = tid; idx < 4 * 128; idx += 512) { const int which = idx >> 7, d = idx & 127; const int h = (which * 5 + 1 + blockIdx.x) & 15, n = (which * 11 + 2 + blockIdx.x * 7) & 31; float s = 0.f;
        for (int r = 0; r < 256; ++r) s += bfu(Kb[(size_t)(n * 256 + r) * D + h * HD + d]); chk_add(A, s / 256.f, KMEAN[((size_t)h * 32 + n) * HD + d]); }
    chk_end(A, tid, dbg, 10);
    for (int ti = 0; ti < 32; ++ti) {
        const int t = (int)(blockIdx.x + 256u * ti), own = t >> 8;
        chk_begin(A, tid);
        for (int n = tid; n < MOBA_IN; n += 512) { float s = 0.f; for (int k = 0; k < D; ++k) s += bfu(HB[(size_t)t * D + k]) * w_in[(size_t)k * MOBA_IN + n];
            float mine; const int seg = n >> 11, cn = n & 2047;
            if (seg == 0) mine = bfu(Q[(size_t)t * D + cn]); else if (seg == 1) mine = bfu(Kb[(size_t)t * D + cn]); else if (seg == 2) mine = bfu(V[(size_t)t * D + cn]); else { mine = bfu(SG[(size_t)t * D + cn]); s = s / (1.f + expf(-s)); }
            chk_add(A, s, mine); }
        chk_end(A, tid, dbg, 9);
        __syncthreads();
        { LAS float* gg = pbuf;
          for (int idx = tid; idx < 16 * 32; idx += 512) { const int h = idx >> 5, n = idx & 31; float s = -3e38f;
              if (n < own) { s = 0.f; for (int d = 0; d < HD; ++d) s += bfu(Q[(size_t)t * D + h * HD + d]) * KMEAN[((size_t)h * 32 + n) * HD + d]; } gg[idx] = s; }
          __syncthreads();
          if (tid < 16) { const int h = tid;
              for (int r = 0; r < 3; ++r) { int best = -1; float bv = -1e38f; for (int n = 0; n < 32; ++n) if (gg[h * 32 + n] > bv) { bv = gg[h * 32 + n]; best = n; } blks[h * 4 + r] = best; if (best >= 0) gg[h * 32 + best] = -3e38f; }
              blks[h * 4 + 3] = own; } }
        __syncthreads();
        for (int idx = tid; idx < 16 * 1024; idx += 512) { const int h = idx >> 10, b = (idx >> 8) & 3, k = idx & 255; const int blk = blks[h * 4 + b]; float l = -1e30f;
            if (blk >= 0) { const int pos = blk * 256 + k; if (pos <= t) { float s = 0.f; for (int d = 0; d < HD; ++d) s += bfu(Q[(size_t)t * D + h * HD + d]) * bfu(Kb[(size_t)pos * D + h * HD + d]);
                l = s * QK_SCALE - exp2f(-0.5f * (float)(h + 1)) * (float)(t - pos); } }
            pbuf[idx] = l; }
        __syncthreads();
        if (tid < 16) { float m = -1e30f; for (int k = 0; k < 1024; ++k) m = fmaxf(m, pbuf[tid * 1024 + k]); float sum = 0.f;
            for (int k = 0; k < 1024; ++k) { const float e = pbuf[tid * 1024 + k] > -1e29f ? expf(pbuf[tid * 1024 + k] - m) : 0.f; pbuf[tid * 1024 + k] = e; sum += e; }
            for (int k = 0; k < 1024; ++k) pbuf[tid * 1024 + k] /= sum; }
        chk_begin(A, tid);
        for (int n = tid; n < D; n += 512) { const int h = n >> 7, d = n & 127; float s = 0.f;
            for (int b = 0; b < 4; ++b) { const int blk = blks[h * 4 + b]; if (blk < 0) continue; for (int k = 0; k < 256; ++k) s += pbuf[h * 1024 + b * 256 + k] * bfu(V[(size_t)(blk * 256 + k) * D + n]); }
            chk_add(A, s * bfu(SG[(size_t)t * D + n]), bfu(GACT[(size_t)t * D + n])); (void)d; }
        chk_end(A, tid, dbg, 11);
        chk_begin(A, tid);
        for (int n = tid; n < D; n += 512) { float s = 0.f; for (int k = 0; k < D; ++k) s += bfu(GACT[(size_t)t * D + k]) * w_o[(size_t)k * D + n];
            chk_add(A, DN_ALPHA * X[(size_t)t * D + n] + MOD[(size_t)layer * 6144 + 4096 + n] * s, Z[(size_t)t * D + n]); }
        chk_end(A, tid, dbg, 12);
    }
}


__device__ __forceinline__ void check_post(KA a, unsigned char* ws, LAS unsigned char* lds, int tid, int layer) {
    float* dbg = (float*)(ws + WS_CTL + 4096) + layer * 16;
    ChkAcc A{(LAS float*)(lds + 0), (LAS unsigned*)(lds + 4), (LAS unsigned*)(lds + 8)};
    LAS float* red = (LAS float*)(lds + 64);
    const float* Z = (const float*)(ws + WS_Z); const float* MOD = (const float*)(ws + WS_MOD); const bool last = layer == DEPTH - 1;
    const float* XO = last ? a.out : (const float*)(ws + WS_X1); const bf16_t* HB = (const bf16_t*)(ws + WS_HB);
    for (int ti = 0; ti < 32; ++ti) {
        const int t = (int)(blockIdx.x + 256u * ti);
        __syncthreads(); if (tid == 0) { float s = 0.f; for (int k = 0; k < D; ++k) s += Z[(size_t)t * D + k]; const float mean = s / D; float q = 0.f; for (int k = 0; k < D; ++k) { const float d = Z[(size_t)t * D + k] - mean; q += d * d; }
            red[0] = mean; red[1] = 1.f / sqrtf(q / D + LN_EPS); } __syncthreads();
        const float mean = red[0], rstd = red[1];
        if (!last) { chk_begin(A, tid);
            for (int n = tid; n < D; n += 512) { const float y = (Z[(size_t)t * D + n] - mean) * rstd * a.in[4][layer * D + n] + a.in[5][layer * D + n]; chk_add(A, y, XO[(size_t)t * D + n]); }
            chk_end(A, tid, dbg, 13);
            chk_begin(A, tid);
            for (int n = tid; n < D; n += 512) { const float y = (Z[(size_t)t * D + n] - mean) * rstd * a.in[4][layer * D + n] + a.in[5][layer * D + n];
                chk_add(A, y * (1.f + MOD[(size_t)(layer + 1) * 6144 + 2048 + n]) + MOD[(size_t)(layer + 1) * 6144 + n], bfu(HB[(size_t)t * D + n])); }
            chk_end(A, tid, dbg, 14); }
    }
    if (layer == 0 && blockIdx.x == 0) {
        chk_begin(A, tid);
        for (int idx = tid; idx < 4 * 6144; idx += 512) { const int i = idx / 6144, n = idx % 6144; float s = a.in[3][idx];
            for (int k = 0; k < D; ++k) { const float cv = a.in[1][k]; s += cv / (1.f + expf(-cv)) * a.in[2][((size_t)i * D + k) * 6144 + n]; } chk_add(A, s, MOD[idx]); }
        chk_end(A, tid, dbg, 15);
    }
}
__device__ __forceinline__ void check_h0(KA a, unsigned char* ws, LAS unsigned char* lds, int tid) {
    float* dbg = (float*)(ws + WS_CTL + 4096);
    ChkAcc A{(LAS float*)(lds + 0), (LAS unsigned*)(lds + 4), (LAS unsigned*)(lds + 8)};
    const float* MOD = (const float*)(ws + WS_MOD); const bf16_t* HB = (const bf16_t*)(ws + WS_HB);
    chk_begin(A, tid);
    for (int ti = 0; ti < 32; ++ti) { const int t = (int)(blockIdx.x + 256u * ti);
        for (int n = tid; n < D; n += 512) chk_add(A, a.in[0][(size_t)t * D + n] * (1.f + MOD[2048 + n]) + MOD[n], bfu(HB[(size_t)t * D + n])); }
    chk_end(A, tid, dbg, 8);
}

enum PhaseKind { PK_P0 = 0, PK_P1, PK_DSA_IN, PK_DSA_Q, PK_DSA_SC, PK_DSA_ATT, PK_DSA_UV, PK_WO, PK_LN, PK_MOBA_IN, PK_MOBA_ATT, PK_MOBA_GATE, PK_MOBA_COMB };
__host__ __device__ constexpr int base_phase_kind(int ph, int& layer) {
    if (ph < 2) { layer = 0; return ph; }
    int p = ph - 2;
    for (int L = 0; L < DEPTH; ++L) {
        const int n = (L & 1) ? 6 : 7;
        if (p < n) { layer = L; if (L & 1) { constexpr int k[6] = {PK_MOBA_IN, PK_MOBA_GATE, PK_MOBA_ATT, PK_MOBA_COMB, PK_WO, PK_LN}; return k[p]; } else { constexpr int k[7] = {PK_DSA_IN, PK_DSA_Q, PK_DSA_SC, PK_DSA_ATT, PK_DSA_UV, PK_WO, PK_LN}; return k[p]; } }
        p -= n;
    }
    layer = 0; return -1;
}
constexpr int N_BASE_PHASES = 2 + 2 * 7 + 2 * 6;
__host__ __device__ constexpr int count_phases() { int n = 0; for (int p = 0; p < N_BASE_PHASES; ++p) { int l = 0; const int k = base_phase_kind(p, l); n += (MK_REP_KIND >= 0 && k == MK_REP_KIND) ? 2 : 1; } return n; }
constexpr int N_PHASES = count_phases();
__host__ __device__ constexpr int phase_kind(int ph, int& layer) {
    int n = 0;
    for (int p = 0; p < N_BASE_PHASES; ++p) { int l = 0; const int k = base_phase_kind(p, l); const int w = (MK_REP_KIND >= 0 && k == MK_REP_KIND) ? 2 : 1; if (ph < n + w) { layer = l; return k; } n += w; }
    layer = 0; return -1;
}

template <bool COOP>
__global__ void __launch_bounds__(512, 2) mk_fwd(Args a0) {
    extern __shared__ __attribute__((aligned(16))) unsigned char lds_raw[];
    const int wave0 = __builtin_amdgcn_readfirstlane((int)threadIdx.x >> 6);
    for (int ph = a0.ph_lo; ph < a0.ph_hi; ++ph) {
        const __attribute__((address_space(4))) Args* ka = (const __attribute__((address_space(4))) Args*)__builtin_amdgcn_kernarg_segment_ptr();
        asm volatile("" : "+s"(ka));
        KA a = *ka;
        unsigned ones_ = ~0u; asm volatile("" : "+s"(ones_));
        int tid_ = wave0 * 64 + (int)__builtin_amdgcn_mbcnt_hi(ones_, __builtin_amdgcn_mbcnt_lo(ones_, 0u)); asm volatile("" : "+v"(tid_));
        Ctx c;
        c.lds = (LAS unsigned char*)lds_raw;
        c.tid = tid_; c.lane = c.tid & 63; c.wave = __builtin_amdgcn_readfirstlane(c.tid >> 6);
        c.G = gridDim.x; { const int bx = blockIdx.x; c.vcu = (c.G % 8 == 0) ? (bx % 8) * (c.G / 8) + bx / 8 : bx; }
        c.gw = c.vcu * 8 + c.wave; c.NGW = c.G * 8;
        unsigned char* ws = a.ws;
        int layer = 0; const int kind = phase_kind(ph, layer); const int j = layer >> 1;
        unsigned char* wd = ws + WS_WD0 + (size_t)j * WD_SIZE; unsigned char* wm = ws + WS_WM0 + (size_t)j * WM_SIZE;
        pg8::StaticOrder so;
        switch (kind) {
        case PK_P0: if (EN(PK_P0)) { phase_p0(a, c); } break;
        case PK_P1: if (EN(PK_P1)) { phase_p1(a, c); } break;
        case PK_DSA_IN: if (EN(PK_DSA_IN)) {
            pg8::Gemm g{(const bf16_t*)(ws + WS_HB), (const bf16_t*)(wd + WD_WIN), S, DSA_INP, D, D, D, 0}; so.init(S, DSA_INP, c.G, (int)blockIdx.x);
            pg8::EpiDsaIn E{(bf16_t*)(ws + WU_CQ), (float*)(ws + WU_CKV), (bf16_t*)(ws + WU_KIDX), (float*)(ws + WS_WIDX), (bf16_t*)(ws + WS_SG), (float*)(ws + WS_SSQ)};
            pg8::gemm_phase(c.lds, c.tid, g, so, E); } break;
        case PK_DSA_Q: if (EN(PK_DSA_Q)) {
            pg8::Gemm g{(const bf16_t*)(ws + WU_CQ), (const bf16_t*)(wd + WD_W2), S, 6144, QR, QR, QR, 0}; so.init(S, 6144, c.G, (int)blockIdx.x);
            pg8::EpiDsaQ E{(bf16_t*)(ws + WU_QLAT), (bf16_t*)(ws + WU_QIDX), (const float*)(ws + WS_SSQ)};
            pg8::gemm_phase(c.lds, c.tid, g, so, E);
            dsa_ckv_norm(a, c, j); } break;
        case PK_DSA_SC: if (EN(PK_DSA_SC)) { phase_idx_scores(a, c); } break;
        case PK_DSA_ATT: if (EN(PK_DSA_ATT)) { phase_dsa_attn(a, c); } break;
        case PK_DSA_UV: if (EN(PK_DSA_UV)) {
            pg8::Gemm g{(const bf16_t*)(ws + WU_OLAT), (const bf16_t*)(wd + WD_WUV), S, D, 512, 4096, 512, 512}; so.init(S, D, c.G, (int)blockIdx.x);
            pg8::EpiUV E{(const bf16_t*)(ws + WS_SG), (bf16_t*)(ws + WS_GACT)};
            pg8::gemm_phase(c.lds, c.tid, g, so, E); } break;
        case PK_WO: if (EN(PK_WO)) {
            pg8::Gemm g{(const bf16_t*)(ws + WS_GACT), (const bf16_t*)((layer & 1) ? wm + WM_WO : wd + WD_WO), S, D, D, D, D, 0}; so.init(S, D, c.G, (int)blockIdx.x);
            pg8::EpiZ E{layer == 0 ? a.in[0] : (const float*)(ws + WS_X1), (const float*)(ws + WS_MOD) + (size_t)layer * 6144 + 4096, (float*)(ws + WS_Z)};
            pg8::gemm_phase(c.lds, c.tid, g, so, E); } break;
        case PK_LN: if (EN(PK_LN)) {
            phase_ln(a, c, layer); } break;
        case PK_MOBA_IN: if (EN(PK_MOBA_IN)) {
            pg8::Gemm g{(const bf16_t*)(ws + WS_HB), (const bf16_t*)(wm + WM_WIN), S, MOBA_IN, D, D, D, 0}; so.init(S, MOBA_IN, c.G, (int)blockIdx.x);
            pg8::EpiMobaIn E{(bf16_t*)(ws + WU_Q), (bf16_t*)(ws + WS_SG), (float*)(ws + WS_KMEAN) + (size_t)j * NH * 32 * HD};
            pg8::gemm_phase(c.lds, c.tid, g, so, E); } break;
        case PK_MOBA_GATE: if (EN(PK_MOBA_GATE)) { phase_moba_gate(a, c, j); } break;
        case PK_MOBA_ATT: if (EN(PK_MOBA_ATT)) { phase_moba_attn(a, c, j); } break;
        case PK_MOBA_COMB: if (EN(PK_MOBA_COMB)) { phase_moba_combine(a, c); } break;
        default: break;
        }
        if (COOP) { if (ph + 1 < a0.ph_hi) cg::this_grid().sync(); }
    }
}

#if MK_CHECK
__global__ void __launch_bounds__(512, 1) chk_kernel(Args a0) {
    extern __shared__ __attribute__((aligned(16))) unsigned char lds_raw[];
    const __attribute__((address_space(4))) Args* ka = (const __attribute__((address_space(4))) Args*)__builtin_amdgcn_kernarg_segment_ptr();
    KA a = *ka;
    const int layer = a0.ph_lo, mode = a0.ph_hi;
    if (mode == 0) { if ((layer & 1) == 0) check_dsa(a, a0.ws, (LAS unsigned char*)lds_raw, (int)threadIdx.x, layer); else check_moba(a, a0.ws, (LAS unsigned char*)lds_raw, (int)threadIdx.x, layer); }
    else if (mode == 1) check_post(a, a0.ws, (LAS unsigned char*)lds_raw, (int)threadIdx.x, layer);
    else check_h0(a, a0.ws, (LAS unsigned char*)lds_raw, (int)threadIdx.x);
}
#endif
extern "C" void kernel_launch(void* const* d_in, const int* in_sizes, int n_in, void* d_out, int out_size, void* d_ws, size_t ws_size, hipStream_t stream) {
    static int grid = 0;
    if (grid == 0) {
        if (n_in != 16 || in_sizes[0] != S * D || out_size != S * D || ws_size < WS_END) {
            fprintf(stderr, "kernel_launch: unexpected shapes: n_in %d in0 %d out %d ws %zu (need %zu)\n", n_in, n_in > 0 ? in_sizes[0] : -1, out_size, ws_size, (size_t)WS_END); grid = -1; return; }
        int dev = 0, cus = 0, per_cu = 0;
        if (hipGetDevice(&dev) != hipSuccess || hipDeviceGetAttribute(&cus, hipDeviceAttributeMultiprocessorCount, dev) != hipSuccess) { grid = -1; return; }
        #if MK_ONE_LAUNCH
        const void* fn = (const void*)mk_fwd<true>;
#else
        const void* fn = (const void*)mk_fwd<false>;
#endif
        if (hipFuncSetAttribute(fn, hipFuncAttributeMaxDynamicSharedMemorySize, LDS_BYTES) != hipSuccess) { fprintf(stderr, "kernel_launch: hipFuncSetAttribute failed\n"); grid = -1; return; }
        if (hipOccupancyMaxActiveBlocksPerMultiprocessor(&per_cu, fn, 512, LDS_BYTES) != hipSuccess || per_cu < 1) { fprintf(stderr, "kernel_launch: occupancy query says %d blocks per CU\n", per_cu); per_cu = 1; }
        (void)hipGetLastError();
        grid = cus * 1;
    }
    if (grid < 0) return;
    Args a{};
    for (int i = 0; i < 16; ++i) a.in[i] = (const float*)d_in[i];
    a.out = (float*)d_out; a.ws = (unsigned char*)d_ws;
#if MK_ONE_LAUNCH
    a.ph_lo = 0; a.ph_hi = N_PHASES;
    void* params[] = {&a};
    hipError_t e = hipLaunchCooperativeKernel((const void*)mk_fwd<true>, dim3(grid), dim3(512), params, LDS_BYTES, stream);
    if (e != hipSuccess) fprintf(stderr, "kernel_launch: cooperative launch failed: %s (grid %d)\n", hipGetErrorString(e), grid);
#else
    for (int ph = 0; ph < N_PHASES; ++ph) {
#if MK_CHECK
        int layer_ = 0; const int kind_ = phase_kind(ph, layer_);
        { static bool once = false; if (!once) { once = true; (void)hipFuncSetAttribute((const void*)chk_kernel, hipFuncAttributeMaxDynamicSharedMemorySize, LDS_BYTES); } }
        if (kind_ == PK_LN) { a.ph_lo = layer_; a.ph_hi = 0; hipLaunchKernelGGL(chk_kernel, dim3(256), dim3(512), LDS_BYTES, stream, a); }
        if (ph == 2) { a.ph_lo = 0; a.ph_hi = 2; hipLaunchKernelGGL(chk_kernel, dim3(256), dim3(512), LDS_BYTES, stream, a); }
#endif
        a.ph_lo = ph; a.ph_hi = ph + 1;
        hipLaunchKernelGGL(mk_fwd<false>, dim3(grid), dim3(512), LDS_BYTES, stream, a);
#if MK_CHECK
        if (kind_ == PK_LN && layer_ < DEPTH - 1) { a.ph_lo = layer_; a.ph_hi = 1; hipLaunchKernelGGL(chk_kernel, dim3(256), dim3(512), LDS_BYTES, stream, a); }
#endif
    }
    const hipError_t le = hipPeekAtLastError();
    if (le != hipSuccess) fprintf(stderr, "kernel_launch: launch failed: %s\n", hipGetErrorName(le));
#endif
}
```

```cpp
#include <hip/hip_runtime.h>
#include <hip/hip_cooperative_groups.h>
#include <cstdio>
#include <cstdint>
namespace cg = cooperative_groups;

#ifndef MK_ONE_LAUNCH
#define MK_ONE_LAUNCH 1
#endif
#ifndef MK_ONLY
#define MK_ONLY -1
#endif
#define EN(k) (MK_ONLY < 0 || MK_ONLY == (k))
#ifndef MK_CHECK
#define MK_CHECK 0
#endif
#ifndef MK_CHECK_STAGE
#define MK_CHECK_STAGE -1
#endif
#ifndef MK_REP_KIND
#define MK_REP_KIND -1
#endif
constexpr int DBG_WORDS = 64;

#define LAS __attribute__((address_space(3)))
typedef unsigned short bf16_t;
typedef short bf16x8 __attribute__((ext_vector_type(8)));
typedef float f32x4 __attribute__((ext_vector_type(4)));
typedef float f32x16 __attribute__((ext_vector_type(16)));
typedef unsigned u32x4 __attribute__((ext_vector_type(4)));
typedef unsigned u32x2 __attribute__((ext_vector_type(2)));
typedef __bf16 bf2_t __attribute__((ext_vector_type(2)));

constexpr int S = 8192, D = 2048, NH = 16, HD = 128, QR = 512, KVR = 256, DEPTH = 4;
constexpr int DSA_IN = 2960, DSA_INP = 3072, MOBA_IN = 8192;
constexpr float LN_EPS = 1e-5f;
constexpr float DN_ALPHA = 1.6817928305074290f;
constexpr float QK_SCALE = 0.088388347648318440f;
constexpr float LOG2E = 1.4426950408889634f;

constexpr size_t MiB = 1u << 20;
constexpr size_t WS_CTL = 0;
constexpr size_t WS_MODP = 1 * MiB;
constexpr size_t WS_MOD = 3 * MiB;
constexpr size_t WS_KMEAN = 3 * MiB + 512 * 1024;
constexpr size_t WS_SSQ = 4 * MiB;
constexpr size_t WS_WIDX = 5 * MiB;
constexpr size_t WS_WGT = 8 * MiB;
constexpr size_t WD_WIN = 0, WD_W2 = (size_t)DSA_INP * D * 2, WD_WUV = WD_W2 + (size_t)6144 * 512 * 2, WD_WO = WD_WUV + (size_t)2048 * 512 * 2, WD_SIZE = WD_WO + (size_t)D * D * 2;
constexpr size_t WM_WIN = 0, WM_WO = (size_t)MOBA_IN * D * 2, WM_SIZE = WM_WO + (size_t)D * D * 2;
constexpr size_t WS_WD0 = WS_WGT, WS_WM0 = WS_WGT + 2 * WD_SIZE;
constexpr size_t WS_X1 = WS_WM0 + 2 * WM_SIZE;
constexpr size_t WS_Z = WS_X1 + 64 * MiB;
constexpr size_t WS_HB = WS_Z + 64 * MiB;
constexpr size_t WS_GACT = WS_HB + 32 * MiB;
constexpr size_t WS_SG = WS_GACT + 32 * MiB;
constexpr size_t WS_U = WS_SG + 32 * MiB;
constexpr size_t WU_CQ = WS_U, WU_CKV = WU_CQ + 8 * MiB, WU_CKVN = WU_CKV + 8 * MiB, WU_KIDX = WU_CKVN + 4 * MiB, WU_QLAT = WU_KIDX + 2 * MiB,
                 WU_QIDX = WU_QLAT + 64 * MiB, WU_SC = WU_QIDX + 32 * MiB, WU_OLAT = WU_SC + 128 * MiB, WU_DEND = WU_OLAT + 64 * MiB;
constexpr size_t WU_Q = WS_U, WU_K = WU_Q + 32 * MiB, WU_V = WU_K + 32 * MiB, WU_OPART = WU_V + 32 * MiB  , WU_ML = WU_OPART + 128 * MiB  ,
                 WU_LIST = WU_ML + 4 * MiB  , WU_MEND = WU_LIST + 8 * MiB;
constexpr size_t WS_CNT = 6 * MiB;
constexpr size_t WS_END = WU_DEND > WU_MEND ? WU_DEND : WU_MEND;
static_assert(WU_K == WU_Q + 32 * MiB && WU_V == WU_Q + 64 * MiB, "Q|K|V spacing");
static_assert(WD_SIZE == 28 * MiB && WM_SIZE == 40 * MiB && WS_X1 == 144 * MiB, "ws map");

constexpr int LDS_PHASE = 147456;
constexpr int LDS_BYTES = LDS_PHASE + 256;

struct Args {
    const float* in[16];
    float* out;
    unsigned char* ws;
    int ph_lo, ph_hi;
};
typedef const __attribute__((address_space(4))) Args& KA;

__device__ __forceinline__ unsigned f2bf(float f) { unsigned u = __builtin_bit_cast(unsigned, f); return (u + 0x7fffu + ((u >> 16) & 1u)) >> 16; }
__device__ __forceinline__ unsigned pk2(float lo, float hi) { return f2bf(lo) | (f2bf(hi) << 16); }
__device__ __forceinline__ unsigned cvt_pk_bf16(float lo, float hi) { unsigned r; asm volatile("v_cvt_pk_bf16_f32 %0, %1, %2" : "=v"(r) : "v"(lo), "v"(hi)); return r; }
__device__ __forceinline__ float bf_lo(unsigned w) { return __builtin_bit_cast(float, w << 16); }
__device__ __forceinline__ float bf_hi(unsigned w) { return __builtin_bit_cast(float, w & 0xffff0000u); }
__device__ __forceinline__ float dot2bf(unsigned a, unsigned b, float c) { return __builtin_amdgcn_fdot2_f32_bf16(__builtin_bit_cast(bf2_t, a), __builtin_bit_cast(bf2_t, b), c, false); }
__device__ __forceinline__ float silu_f(float x) { return x * __builtin_amdgcn_rcpf(1.0f + __builtin_amdgcn_exp2f(-x * LOG2E)); }
__device__ __forceinline__ float wave_sum(float v) {
#pragma unroll
    for (int o = 1; o < 64; o <<= 1) v += __shfl_xor(v, o);
    return v;
}
__device__ __forceinline__ float wave_max(float v) {
#pragma unroll
    for (int o = 1; o < 64; o <<= 1) v = fmaxf(v, __shfl_xor(v, o));
    return v;
}
#define LDS_WAIT() asm volatile("s_waitcnt lgkmcnt(0)" ::: "memory")

namespace pg8 {
constexpr int BM = 256, BK = 64, HALF = 128, HTB = HALF * BK * 2, STAGE_BYTES = 8 * HTB, NXCD = 8, WGM = 8;
__host__ __device__ __forceinline__ int lds_byte(int r, int c) { const int st = (r >> 4) * 2 + (c >> 5), rr = r & 15, cc = c & 31, ob = rr * 64 + cc * 2; return st * 1024 + (ob ^ (((ob >> 9) & 1) << 5)); }
__host__ __device__ __forceinline__ void stage_rc(int b, int& R, int& C) { const int st = b / 1024, sb = b % 1024, swz = sb ^ (((sb >> 9) & 1) << 5); R = (st >> 1) * 16 + swz / 64; C = (st & 1) * 32 + (swz % 64) / 2; }
__host__ __device__ __forceinline__ int perm32(int rho) { const int n = rho >> 4, i = rho & 15; return 8 * (i >> 2) + 4 * n + (i & 3); }

struct Unit { int pm, pn; };
struct Gemm { const bf16_t* A; const bf16_t* Bt; int M, N, K, lda, ldb; long a_pn_off; };

struct StaticOrder {
    int nM, nN, nwg, G, c;
    __host__ __device__ void init(int M, int N, int G_, int c_) { nM = M / BM; nN = N / BM; nwg = nM * nN; G = G_; c = c_; }
    __host__ __device__ bool next(int i, Unit& u) const {
        const long L = (long)i * G + c; if (L >= nwg) return false;
        int wgid = (int)L; { const int q = nwg / NXCD, r = nwg % NXCD, xcd = wgid % NXCD, off = wgid / NXCD; wgid = (xcd < r ? xcd * (q + 1) : r * (q + 1) + (xcd - r) * q) + off; }
        const int nig = WGM * nN, gid = wgid / nig, fm = gid * WGM, gsz = (nM - fm) < WGM ? (nM - fm) : WGM;
        u.pm = fm + ((wgid % nig) % gsz); u.pn = (wgid % nig) / gsz; return true;
    }
};

template <class Epi>
__device__ __forceinline__ void gemm_phase(LAS unsigned char* lds, const int tid, const Gemm g, const StaticOrder& S, const Epi& E) {
    const int wid = __builtin_amdgcn_readfirstlane(tid >> 6), lane = tid & 63, wr = wid >> 2, wc = wid & 3, fr = lane & 15, fq = lane >> 4;
    const int K = g.K, nt = K / BK;
    unsigned voffA[2], voffB[2];
#pragma unroll
    for (int i = 0; i < 2; ++i) { int R, C; stage_rc(tid * 16 + i * 8192, R, C); const int Rb = Epi::PERM ? ((R & ~31) + perm32(R & 31)) : R;
        voffA[i] = (unsigned)(R * g.lda + C) * 2u; voffB[i] = (unsigned)(Rb * g.ldb + C) * 2u; }
    const size_t kstep = (size_t)(BK * 2);
    const size_t hstepA = (size_t)HALF * g.lda * 2, hstepB = (size_t)HALF * g.ldb * 2;
    const size_t tstepA = 2 * hstepA, tstepB = 2 * hstepB;
    const size_t pnA = (size_t)g.a_pn_off * 2;
    const unsigned ldsw = (unsigned)wid * 1024u;
    const int aoff = lds_byte(wr * 64 + fr, fq * 8), boff = lds_byte(wc * 32 + fr, fq * 8);
#define PG8_SA(b, h) (((b) * 2 + (h)) * HTB)
#define PG8_SB(b, h) ((4 + (b) * 2 + (h)) * HTB)
#define PG8_STAGE(bufoff, gbase, voff) do { _Pragma("unroll") for (int _i = 0; _i < 2; ++_i) \
        __builtin_amdgcn_global_load_lds((const unsigned*)((const char*)(gbase) + (voff)[_i]), (LAS unsigned*)(lds + (bufoff) + ldsw + _i * 8192), 16, 0, 0); } while (0)
#define PG8_LDA(dst, b, h) do { _Pragma("unroll") for (int m = 0; m < 4; ++m) _Pragma("unroll") for (int k = 0; k < 2; ++k) dst[m][k] = *(const LAS bf16x8*)(lds + PG8_SA(b, h) + aoff + m * 2048 + k * 1024); } while (0)
#define PG8_LDB(dst, b, h) do { _Pragma("unroll") for (int n = 0; n < 2; ++n) _Pragma("unroll") for (int k = 0; k < 2; ++k) dst[n][k] = *(const LAS bf16x8*)(lds + PG8_SB(b, h) + boff + n * 2048 + k * 1024); } while (0)
#define PG8_MMA(ai, bj, At, Bt) do { __builtin_amdgcn_s_setprio(1); _Pragma("unroll") for (int m = 0; m < 4; ++m) _Pragma("unroll") for (int n = 0; n < 2; ++n) _Pragma("unroll") for (int k = 0; k < 2; ++k) \
        acc[ai][bj][m][n] = __builtin_amdgcn_mfma_f32_16x16x32_bf16(Bt[n][k], At[m][k], acc[ai][bj][m][n], 0, 0, 0); __builtin_amdgcn_s_setprio(0); } while (0)
#define PG8_WAIT_V(n) asm volatile("s_waitcnt vmcnt(" #n ")" ::: "memory")
#define PG8_WAIT_L(n) asm volatile("s_waitcnt lgkmcnt(" #n ")" ::: "memory")
#define PG8_BAR __builtin_amdgcn_s_barrier()
#define PG8_SCHED __builtin_amdgcn_sched_barrier(0)
    Unit cur, nxt; int ui = 0;
    if (!S.next(0, cur)) return;
    f32x4 acc[2][2][4][2];
#pragma unroll
    for (int a = 0; a < 2; ++a)
#pragma unroll
        for (int b = 0; b < 2; ++b)
#pragma unroll
            for (int m = 0; m < 4; ++m)
#pragma unroll
                for (int n = 0; n < 2; ++n) acc[a][b][m][n] = (f32x4){0.f, 0.f, 0.f, 0.f};
    bf16x8 At[4][2], B0[2][2], B1[2][2];
    const char* cA = (const char*)g.A + (size_t)cur.pm * tstepA + (size_t)cur.pn * pnA; const char* cB = (const char*)g.Bt + (size_t)cur.pn * tstepB;
    PG8_STAGE(PG8_SB(0, 0), cB, voffB); PG8_STAGE(PG8_SB(0, 1), cB + hstepB, voffB); PG8_STAGE(PG8_SA(0, 0), cA, voffA); PG8_STAGE(PG8_SA(0, 1), cA + hstepA, voffA);
    if (wr == 1) PG8_BAR;
    PG8_WAIT_V(2); PG8_BAR;
    PG8_STAGE(PG8_SB(1, 0), cB + kstep, voffB); PG8_STAGE(PG8_SA(1, 0), cA + kstep, voffA); PG8_STAGE(PG8_SB(1, 1), cB + hstepB + kstep, voffB);
    PG8_WAIT_V(6); PG8_BAR;
    for (;;) {
        const bool has_next = S.next(ui + 1, nxt);
        const char* nA = has_next ? (const char*)g.A + (size_t)nxt.pm * tstepA + (size_t)nxt.pn * pnA : cA; const char* nB = has_next ? (const char*)g.Bt + (size_t)nxt.pn * tstepB : cB;
        for (int t = 0; t < nt; t += 2) {
            const bool last = (t == nt - 2);
            const char* a1 = cA + (size_t)(t + 1) * kstep;
            const char* a2 = last ? nA : cA + (size_t)(t + 2) * kstep; const char* b2 = last ? nB : cB + (size_t)(t + 2) * kstep;
            const char* a3 = a2 + kstep; const char* b3 = b2 + kstep;
            PG8_LDB(B0, 0, 0); PG8_LDB(B1, 0, 1); PG8_SCHED; PG8_LDA(At, 0, 0); PG8_STAGE(PG8_SA(1, 1), a1 + hstepA, voffA);
            PG8_WAIT_V(8); PG8_WAIT_L(0); PG8_BAR; PG8_MMA(0, 0, At, B0); PG8_MMA(0, 1, At, B1); PG8_BAR; PG8_SCHED;
            PG8_LDA(At, 0, 1); PG8_STAGE(PG8_SB(0, 0), b2, voffB); PG8_STAGE(PG8_SB(0, 1), b2 + hstepB, voffB); PG8_STAGE(PG8_SA(0, 0), a2, voffA);
            PG8_WAIT_V(8); PG8_WAIT_L(0); PG8_BAR; PG8_MMA(1, 0, At, B0); PG8_MMA(1, 1, At, B1); PG8_BAR; PG8_SCHED;
            PG8_LDB(B0, 1, 0); PG8_LDB(B1, 1, 1); PG8_SCHED; PG8_LDA(At, 1, 0); PG8_STAGE(PG8_SA(0, 1), a2 + hstepA, voffA);
            PG8_WAIT_V(8); PG8_WAIT_L(0); PG8_BAR; PG8_MMA(0, 0, At, B0); PG8_MMA(0, 1, At, B1); PG8_BAR; PG8_SCHED;
            PG8_LDA(At, 1, 1); PG8_STAGE(PG8_SB(1, 0), b3, voffB); PG8_STAGE(PG8_SB(1, 1), b3 + hstepB, voffB); PG8_STAGE(PG8_SA(1, 0), a3, voffA);
            PG8_WAIT_V(8); PG8_WAIT_L(0); PG8_BAR; PG8_MMA(1, 0, At, B0); PG8_MMA(1, 1, At, B1); PG8_BAR; PG8_SCHED;
        }
        if (wr == 0) PG8_BAR;
        E(acc, cur, wr, wc, fr, fq);
        if (!has_next) break;
#pragma unroll
        for (int a = 0; a < 2; ++a)
#pragma unroll
            for (int b = 0; b < 2; ++b)
#pragma unroll
                for (int m = 0; m < 4; ++m)
#pragma unroll
                    for (int n = 0; n < 2; ++n) acc[a][b][m][n] = (f32x4){0.f, 0.f, 0.f, 0.f};
        cur = nxt; cA = nA; cB = nB; ++ui;
        if (wr == 1) PG8_BAR;
    }
    PG8_WAIT_V(0);
    PG8_BAR;
#undef PG8_SA
#undef PG8_SB
#undef PG8_STAGE
#undef PG8_LDA
#undef PG8_LDB
#undef PG8_MMA
#undef PG8_WAIT_V
#undef PG8_WAIT_L
#undef PG8_BAR
#undef PG8_SCHED
}

__device__ __forceinline__ u32x4 pack8(f32x4 v0, f32x4 v1) { u32x4 w; w.x = cvt_pk_bf16(v0[0], v0[1]); w.y = cvt_pk_bf16(v0[2], v0[3]); w.z = cvt_pk_bf16(v1[0], v1[1]); w.w = cvt_pk_bf16(v1[2], v1[3]); return w; }

struct EpiDsaIn {
    static constexpr bool PERM = true;
    bf16_t* CQ; float* CKV; bf16_t* KIDX; float* WIDX; bf16_t* SG; float* SSQ;
    __device__ __forceinline__ void operator()(const f32x4 (&acc)[2][2][4][2], const Unit& u, int wr, int wc, int fr, int fq) const {
        const int row0 = u.pm * BM + wr * 64 + fr, pn = u.pn, cw = wc * 32 + 8 * fq;
        if (pn < 3) {
#pragma unroll
            for (int ai = 0; ai < 2; ++ai)
#pragma unroll
                for (int m = 0; m < 4; ++m) { const int row = row0 + ai * HALF + m * 16; float s = 0.f;
#pragma unroll
                    for (int bj = 0; bj < 2; ++bj) { const f32x4 v0 = acc[ai][bj][m][0], v1 = acc[ai][bj][m][1];
                        s += (v0[0] * v0[0] + v0[1] * v0[1]) + (v0[2] * v0[2] + v0[3] * v0[3]) + (v1[0] * v1[0] + v1[1] * v1[1]) + (v1[2] * v1[2] + v1[3] * v1[3]);
                        if (pn < 2) *(u32x4*)(CQ + (size_t)row * QR + pn * 256 + bj * HALF + cw) = pack8(v0, v1);
                        else { float* p = CKV + (size_t)row * KVR + bj * HALF + cw; *(f32x4*)p = v0; *(f32x4*)(p + 4) = v1; } }
                    s += __shfl_xor(s, 16); s += __shfl_xor(s, 32);
                    if (fq == 0) SSQ[(size_t)row * 12 + (pn < 2 ? pn * 4 : 8) + wc] = s; }
        } else if (pn == 3) {
#pragma unroll
            for (int ai = 0; ai < 2; ++ai)
#pragma unroll
                for (int m = 0; m < 4; ++m) { const int row = row0 + ai * HALF + m * 16;
                    *(u32x4*)(KIDX + (size_t)row * 128 + cw) = pack8(acc[ai][0][m][0], acc[ai][0][m][1]);
                    if (wc == 0 && fq < 2) { float* p = WIDX + (size_t)row * 16 + 8 * fq; *(f32x4*)p = acc[ai][1][m][0] * 0.25f; *(f32x4*)(p + 4) = acc[ai][1][m][1] * 0.25f; } }
        } else {
#pragma unroll
            for (int ai = 0; ai < 2; ++ai)
#pragma unroll
                for (int m = 0; m < 4; ++m) { const int row = row0 + ai * HALF + m * 16;
#pragma unroll
                    for (int bj = 0; bj < 2; ++bj) { f32x4 v0 = acc[ai][bj][m][0], v1 = acc[ai][bj][m][1];
#pragma unroll
                        for (int j = 0; j < 4; ++j) { v0[j] = silu_f(v0[j]); v1[j] = silu_f(v1[j]); }
                        *(u32x4*)(SG + (size_t)row * D + (pn - 4) * 256 + bj * HALF + cw) = pack8(v0, v1); } }
        }
    }
};
struct EpiDsaQ {
    static constexpr bool PERM = true;
    bf16_t* QLAT; bf16_t* QIDX; const float* SSQ;
    __device__ __forceinline__ void operator()(const f32x4 (&acc)[2][2][4][2], const Unit& u, int wr, int wc, int fr, int fq) const {
        const int row0 = u.pm * BM + wr * 64 + fr, pn = u.pn, cw = wc * 32 + 8 * fq;
#pragma unroll
        for (int ai = 0; ai < 2; ++ai)
#pragma unroll
            for (int m = 0; m < 4; ++m) { const int row = row0 + ai * HALF + m * 16;
                const f32x4 p0 = *(const f32x4*)(SSQ + (size_t)row * 12), p1 = *(const f32x4*)(SSQ + (size_t)row * 12 + 4);
                const float ss = ((p0[0] + p0[1]) + (p0[2] + p0[3])) + ((p1[0] + p1[1]) + (p1[2] + p1[3]));
                const float rs = __builtin_amdgcn_rsqf(ss * (1.0f / QR) + LN_EPS);
                bf16_t* dst = pn < 16 ? QLAT + (size_t)row * 4096 + pn * 256 : QIDX + (size_t)row * 2048 + (pn - 16) * 256;
#pragma unroll
                for (int bj = 0; bj < 2; ++bj) *(u32x4*)(dst + bj * HALF + cw) = pack8(acc[ai][bj][m][0] * rs, acc[ai][bj][m][1] * rs); }
    }
};
struct EpiUV {
    static constexpr bool PERM = true;
    const bf16_t* SG; bf16_t* GACT;
    __device__ __forceinline__ void operator()(const f32x4 (&acc)[2][2][4][2], const Unit& u, int wr, int wc, int fr, int fq) const {
        const int row0 = u.pm * BM + wr * 64 + fr, cw = u.pn * BM + wc * 32 + 8 * fq;
#pragma unroll
        for (int ai = 0; ai < 2; ++ai)
#pragma unroll
            for (int m = 0; m < 4; ++m) { const size_t off = (size_t)(row0 + ai * HALF + m * 16) * D + cw;
#pragma unroll
                for (int bj = 0; bj < 2; ++bj) { const u32x4 g = *(const u32x4*)(SG + off + bj * HALF);
                    f32x4 v0 = acc[ai][bj][m][0], v1 = acc[ai][bj][m][1];
                    v0[0] *= bf_lo(g.x); v0[1] *= bf_hi(g.x); v0[2] *= bf_lo(g.y); v0[3] *= bf_hi(g.y);
                    v1[0] *= bf_lo(g.z); v1[1] *= bf_hi(g.z); v1[2] *= bf_lo(g.w); v1[3] *= bf_hi(g.w);
                    *(u32x4*)(GACT + off + bj * HALF) = pack8(v0, v1); } }
    }
};
struct EpiZ {
    static constexpr bool PERM = false;
    const float* X; const float* GM; float* Z;
    __device__ __forceinline__ void operator()(const f32x4 (&acc)[2][2][4][2], const Unit& u, int wr, int wc, int fr, int fq) const {
        const int row0 = u.pm * BM + wr * 64 + fr, col0 = u.pn * BM + wc * 32 + 4 * fq;
        f32x4 gm[2][2];
#pragma unroll
        for (int bj = 0; bj < 2; ++bj)
#pragma unroll
            for (int n = 0; n < 2; ++n) gm[bj][n] = *(const f32x4*)(GM + col0 + bj * HALF + n * 16);
#pragma unroll
        for (int ai = 0; ai < 2; ++ai)
#pragma unroll
            for (int m = 0; m < 4; ++m) { const size_t off = (size_t)(row0 + ai * HALF + m * 16) * D + col0;
#pragma unroll
                for (int bj = 0; bj < 2; ++bj)
#pragma unroll
                    for (int n = 0; n < 2; ++n) { const f32x4 xv = *(const f32x4*)(X + off + bj * HALF + n * 16);
                        *(f32x4*)(Z + off + bj * HALF + n * 16) = xv * DN_ALPHA + gm[bj][n] * acc[ai][bj][m][n]; } }
    }
};
struct EpiMobaIn {
    static constexpr bool PERM = true;
    bf16_t* Q; bf16_t* SG; float* KMEAN;
    __device__ __forceinline__ void operator()(const f32x4 (&acc)[2][2][4][2], const Unit& u, int wr, int wc, int fr, int fq) const {
        const int row0 = u.pm * BM + wr * 64 + fr, pn = u.pn, cw = (pn & 7) * 256 + wc * 32 + 8 * fq;
        if (pn < 24) {
            bf16_t* dst = Q + (size_t)(pn >> 3) * (size_t)(16u << 20);
#pragma unroll
            for (int ai = 0; ai < 2; ++ai)
#pragma unroll
                for (int m = 0; m < 4; ++m) { const size_t off = (size_t)(row0 + ai * HALF + m * 16) * D + cw;
#pragma unroll
                    for (int bj = 0; bj < 2; ++bj) *(u32x4*)(dst + off + bj * HALF) = pack8(acc[ai][bj][m][0], acc[ai][bj][m][1]); }
            if (pn >= 8 && pn < 16) {
#pragma unroll
                for (int bj = 0; bj < 2; ++bj)
#pragma unroll
                    for (int n = 0; n < 2; ++n) {
                        float c0 = 0.f, c1 = 0.f, c2 = 0.f, c3 = 0.f;
#pragma unroll
                        for (int ai = 0; ai < 2; ++ai)
#pragma unroll
                            for (int m = 0; m < 4; ++m) { const f32x4 v = acc[ai][bj][m][n]; c0 += v[0]; c1 += v[1]; c2 += v[2]; c3 += v[3]; }
#pragma unroll
                        for (int o = 1; o < 16; o <<= 1) { c0 += __shfl_xor(c0, o); c1 += __shfl_xor(c1, o); c2 += __shfl_xor(c2, o); c3 += __shfl_xor(c3, o); }
                        if (fr == 0) { const int col = cw + bj * HALF + 4 * n; float* p = KMEAN + ((size_t)(col >> 7) * 32 + u.pm) * 128 + (col & 127);
                            atomicAdd(p, c0 * (1.0f / 256.0f)); atomicAdd(p + 1, c1 * (1.0f / 256.0f)); atomicAdd(p + 2, c2 * (1.0f / 256.0f)); atomicAdd(p + 3, c3 * (1.0f / 256.0f)); } }
            }
        } else {
#pragma unroll
            for (int ai = 0; ai < 2; ++ai)
#pragma unroll
                for (int m = 0; m < 4; ++m) { const size_t off = (size_t)(row0 + ai * HALF + m * 16) * D + cw;
#pragma unroll
                    for (int bj = 0; bj < 2; ++bj) { f32x4 v0 = acc[ai][bj][m][0], v1 = acc[ai][bj][m][1];
#pragma unroll
                        for (int j = 0; j < 4; ++j) { v0[j] = silu_f(v0[j]); v1[j] = silu_f(v1[j]); }
                        *(u32x4*)(SG + off + bj * HALF) = pack8(v0, v1); } }
        }
    }
};
}

struct Ctx {
    LAS unsigned char* lds;
    int tid, lane, wave, vcu, G, gw, NGW;
};

template <bool HAS_RS>
__device__ __forceinline__ void cvt_item(const float* src, int ld_src, int n_src0, int nvalid, int k0, bf16_t* dst, int ld_dst, int n_dst0, int kd0, int kz0,
                                         const float* rowscale, float cscale, LAS float* scr, int lane) {
    const int n = lane & 31, kh = lane >> 5;
    float v[32];
    if (nvalid > 0) {
        const int nn = n < nvalid ? n : nvalid - 1; const float mk = n < nvalid ? cscale : 0.f;
        const float* p = src + (size_t)(k0 + kh) * ld_src + n_src0 + nn;
#pragma unroll
        for (int i = 0; i < 32; ++i) v[i] = p[(size_t)(2 * i) * ld_src];
#pragma unroll
        for (int i = 0; i < 32; ++i) { float x = v[i] * mk; if (HAS_RS) x *= rowscale[k0 + 2 * i + kh]; scr[(2 * i + kh) * 33 + n] = x; }
    } else {
#pragma unroll
        for (int i = 0; i < 32; ++i) scr[(2 * i + kh) * 33 + n] = 0.f;
    }
    LDS_WAIT(); asm volatile("" ::: "memory");
    const int c = lane & 7;
#pragma unroll
    for (int j = 0; j < 4; ++j) { const int nr = (lane >> 3) + 8 * j; const LAS float* s = scr + (8 * c) * 33 + nr;
        u32x4 o; o.x = pk2(s[0 * 33], s[1 * 33]); o.y = pk2(s[2 * 33], s[3 * 33]); o.z = pk2(s[4 * 33], s[5 * 33]); o.w = pk2(s[6 * 33], s[7 * 33]);
        *(u32x4*)(dst + (size_t)(n_dst0 + nr) * ld_dst + kd0 + 8 * c) = o;
        if (kz0 >= 0) *(u32x4*)(dst + (size_t)(n_dst0 + nr) * ld_dst + kz0 + 8 * c) = (u32x4){0u, 0u, 0u, 0u}; }
    LDS_WAIT(); asm volatile("" ::: "memory");
}

__device__ __forceinline__ void phase_p0(KA a, const Ctx& c) {
    unsigned char* ws = a.ws;
    {
        const float* cvec = a.in[1]; const float* ada_w = a.in[2]; float* MODP = (float*)(ws + WS_MODP);
        for (int task = c.gw; task < 4 * 16 * 24; task += c.NGW) {
            const int nc = task % 24, kc = (task / 24) % 16, i = task / (24 * 16);
            const float* w = ada_w + ((size_t)i * 2048 + kc * 128) * 6144 + nc * 256 + c.lane * 4;
            f32x4 acc = (f32x4){0.f, 0.f, 0.f, 0.f};
#pragma unroll 16
            for (int k = 0; k < 128; ++k) { const float cv = cvec[kc * 128 + k]; const float sv = silu_f(cv); const f32x4 v = *(const f32x4*)(w + (size_t)k * 6144); acc += v * sv; }
            *(f32x4*)(MODP + (size_t)(kc * 4 + i) * 6144 + nc * 256 + c.lane * 4) = acc;
        }
    }
    {
        LAS float* scr = (LAS float*)(c.lds + c.wave * 8704);
        constexpr int I_A = 32 * 32, I_B = 64 * 32, I_C = 64 * 8, I_D = 16 * 4 * 4, I_E = 64 * 32, I_DSA = I_A + I_B + I_C + I_D + I_E;
        constexpr int I_F = 256 * 32, I_G = 64 * 32, I_MOBA = I_F + I_G, I_ALL = 2 * I_DSA + 2 * I_MOBA;
        for (int it = c.gw; it < I_ALL; it += c.NGW) {
            if (it < 2 * I_DSA) {
                const int j = it / I_DSA; int r = it % I_DSA; unsigned char* wd = ws + WS_WD0 + (size_t)j * WD_SIZE;
                if (r < I_A + I_B) {
                    const int nb = r >> 5, kb = r & 31; const float* src = a.in[6] + (size_t)j * D * DSA_IN;
                    int n_src0, nvalid; if (nb < 32) { n_src0 = nb * 32; nvalid = 912 - n_src0; nvalid = nvalid < 0 ? 0 : (nvalid > 32 ? 32 : nvalid); } else { n_src0 = 912 + (nb - 32) * 32; nvalid = 32; }
                    cvt_item<false>(src, DSA_IN, n_src0, nvalid, kb * 64, (bf16_t*)(wd + WD_WIN), D, nb * 32, kb * 64, -1, nullptr, 1.0f, scr, c.lane);
                    continue; }
                r -= I_A + I_B;
                if (r < I_C) {
                    const int nb = r >> 3, kb = r & 7; const float* src = a.in[10] + (size_t)j * QR * 2048;
                    cvt_item<true>(src, 2048, nb * 32, 32, kb * 64, (bf16_t*)(wd + WD_W2), QR, 4096 + nb * 32, kb * 64, -1, a.in[7] + j * QR, QK_SCALE, scr, c.lane);
                    continue; }
                r -= I_C;
                if (r < I_D) {
                    const int h = r >> 4, nb = (r >> 2) & 3, kb = r & 3; const float* src = a.in[12] + ((size_t)j * NH + h) * KVR * HD;
                    cvt_item<false>(src, HD, nb * 32, 32, kb * 64, (bf16_t*)(wd + WD_WUV), 512, h * HD + nb * 32, (h & 1) * 256 + kb * 64, ((h & 1) ^ 1) * 256 + kb * 64, nullptr, 1.0f, scr, c.lane);
                    continue; }
                r -= I_D;
                { const int nb = r >> 5, kb = r & 31; const float* src = a.in[13] + (size_t)j * D * D;
                  cvt_item<false>(src, D, nb * 32, 32, kb * 64, (bf16_t*)(wd + WD_WO), D, nb * 32, kb * 64, -1, nullptr, 1.0f, scr, c.lane); }
            } else {
                const int q = it - 2 * I_DSA, j = q / I_MOBA; int r = q % I_MOBA; unsigned char* wm = ws + WS_WM0 + (size_t)j * WM_SIZE;
                if (r < I_F) { const int nb = r >> 5, kb = r & 31; const float* src = a.in[14] + (size_t)j * D * MOBA_IN;
                    cvt_item<false>(src, MOBA_IN, nb * 32, 32, kb * 64, (bf16_t*)(wm + WM_WIN), D, nb * 32, kb * 64, -1, nullptr, 1.0f, scr, c.lane); }
                else { r -= I_F; const int nb = r >> 5, kb = r & 31; const float* src = a.in[15] + (size_t)j * D * D;
                    cvt_item<false>(src, D, nb * 32, 32, kb * 64, (bf16_t*)(wm + WM_WO), D, nb * 32, kb * 64, -1, nullptr, 1.0f, scr, c.lane); }
            }
        }
    }
    for (int it = c.vcu; it < 2048; it += c.G) {
        const int j = it >> 10, h = (it >> 6) & 15, k0 = (it & 63) * 8, cc = c.tid & 255, kh = c.tid >> 8;
        const float* uq = a.in[9] + (size_t)j * QR * 2048 + (size_t)(k0 + 4 * kh) * 2048 + h * HD;
        const float* uk = a.in[11] + ((size_t)j * NH + h) * HD * KVR + cc;
        float acc[4] = {0.f, 0.f, 0.f, 0.f};
#pragma unroll 8
        for (int d = 0; d < HD; ++d) { const float b = uk[d * KVR];
#pragma unroll
            for (int i = 0; i < 4; ++i) acc[i] += uq[i * 2048 + d] * b; }
        const float* gq = a.in[7] + j * QR + k0 + 4 * kh;
        u32x2 o; o.x = pk2(acc[0] * gq[0] * QK_SCALE, acc[1] * gq[1] * QK_SCALE); o.y = pk2(acc[2] * gq[2] * QK_SCALE, acc[3] * gq[3] * QK_SCALE);
        *(u32x2*)((bf16_t*)(ws + WS_WD0 + (size_t)j * WD_SIZE + WD_W2) + (size_t)(h * KVR + cc) * QR + k0 + 4 * kh) = o;
    }
#if MK_CHECK
    if (c.vcu == 0 && c.tid < DBG_WORDS) ((float*)(ws + WS_CTL + 4096))[c.tid] = 0.f;
#endif
    { float* km = (float*)(ws + WS_KMEAN); for (int i = c.vcu * 512 + c.tid; i < 2 * NH * 32 * HD; i += c.G * 512) km[i] = 0.f; }
    if (c.vcu == 1) { int* cn = (int*)(ws + WS_CNT); for (int i = c.tid; i < 2 * NH * 32; i += 512) cn[i] = 0; }
}

__device__ __forceinline__ void phase_p1(KA a, const Ctx& c) {
    unsigned char* ws = a.ws; const float* MODP = (const float*)(ws + WS_MODP); const float* ada_b = a.in[3];
    LAS float* tab = (LAS float*)c.lds;
    for (int n = c.tid; n < 4096; n += 512) { float s = ada_b[n];
#pragma unroll
        for (int kc = 0; kc < 16; ++kc) s += MODP[(size_t)(kc * 4 + 0) * 6144 + n];
        tab[n] = n >= 2048 ? 1.0f + s : s; }
    if (c.vcu < 96 && c.tid < 256) { const int idx = c.vcu * 256 + c.tid, i = idx / 6144, n = idx % 6144; float s = ada_b[idx];
#pragma unroll
        for (int kc = 0; kc < 16; ++kc) s += MODP[(size_t)(kc * 4 + i) * 6144 + n];
        ((float*)(ws + WS_MOD))[idx] = s; }
    __syncthreads();
    const float* x = a.in[0]; bf16_t* HB = (bf16_t*)(ws + WS_HB);
    for (int t = c.gw; t < S; t += c.NGW) {
#pragma unroll
        for (int j = 0; j < 8; ++j) { const int col = 4 * c.lane + 256 * j; const f32x4 xv = *(const f32x4*)(x + (size_t)t * D + col);
            const f32x4 sh = *(const LAS f32x4*)(tab + col), sc = *(const LAS f32x4*)(tab + 2048 + col); const f32x4 hv = xv * sc + sh;
            u32x2 o; o.x = pk2(hv[0], hv[1]); o.y = pk2(hv[2], hv[3]); *(u32x2*)(HB + (size_t)t * D + col) = o; }
    }
    __syncthreads();
}

__device__ __forceinline__ void phase_ln(KA a, const Ctx& c, int layer) {
    unsigned char* ws = a.ws; const float* Z = (const float*)(ws + WS_Z); const bool last = layer == DEPTH - 1;
    float* XO = last ? a.out : (float*)(ws + WS_X1); bf16_t* HB = (bf16_t*)(ws + WS_HB);
    const float* g = a.in[4] + layer * D; const float* b = a.in[5] + layer * D;
    const float* modn = (const float*)(ws + WS_MOD) + (size_t)(last ? layer : layer + 1) * 6144;
    float chk_off = 0.f;
#if MK_CHECK
    if (last) { const float* dbg = (const float*)(ws + WS_CTL + 4096);
        if (MK_CHECK_STAGE >= 0) chk_off = dbg[MK_CHECK_STAGE < 0 ? 0 : MK_CHECK_STAGE];
        else { float best = 0.f; int bi = 0; for (int i = 1; i < DBG_WORDS; ++i) if (dbg[i] > best) { best = dbg[i]; bi = i; } chk_off = MK_CHECK_STAGE == -1 ? floorf(fminf(best, 10.f) * 16.f + 0.5f) * (1.f / 16.f) : (float)bi; } }
#endif
    for (int t = c.gw; t < S; t += c.NGW) {
        f32x4 v[8]; float s = 0.f;
#pragma unroll
        for (int j = 0; j < 8; ++j) { v[j] = *(const f32x4*)(Z + (size_t)t * D + 4 * c.lane + 256 * j); s += (v[j][0] + v[j][1]) + (v[j][2] + v[j][3]); }
        const float mean = wave_sum(s) * (1.0f / D); float q = 0.f;
#pragma unroll
        for (int j = 0; j < 8; ++j) { v[j] = v[j] - mean; q += (v[j][0] * v[j][0] + v[j][1] * v[j][1]) + (v[j][2] * v[j][2] + v[j][3] * v[j][3]); }
        const float rstd = 1.0f / sqrtf(wave_sum(q) * (1.0f / D) + LN_EPS);
#pragma unroll
        for (int j = 0; j < 8; ++j) { const int col = 4 * c.lane + 256 * j; const f32x4 gv = *(const f32x4*)(g + col), bv = *(const f32x4*)(b + col);
            const f32x4 y = v[j] * rstd * gv + bv; *(f32x4*)(XO + (size_t)t * D + col) = y + chk_off;
            if (!last) { const f32x4 sh = *(const f32x4*)(modn + col), sc = *(const f32x4*)(modn + 2048 + col); const f32x4 hv = y * (sc + 1.0f) + sh;
                u32x2 o; o.x = pk2(hv[0], hv[1]); o.y = pk2(hv[2], hv[3]); *(u32x2*)(HB + (size_t)t * D + col) = o; } }
    }
}

__device__ __forceinline__ void dsa_ckv_norm(KA a, const Ctx& c, int j) {
    unsigned char* ws = a.ws; const float* CKV = (const float*)(ws + WU_CKV); bf16_t* CKVN = (bf16_t*)(ws + WU_CKVN); const float* SSQ = (const float*)(ws + WS_SSQ);
    const float* gkv = a.in[8] + j * KVR; const f32x4 gv = *(const f32x4*)(gkv + 4 * c.lane);
    for (int t = c.gw; t < S; t += c.NGW) {
        const f32x4 p = *(const f32x4*)(SSQ + (size_t)t * 12 + 8); const float rs = __builtin_amdgcn_rsqf(((p[0] + p[1]) + (p[2] + p[3])) * (1.0f / KVR) + LN_EPS);
        const f32x4 v = *(const f32x4*)(CKV + (size_t)t * KVR + 4 * c.lane) * rs * gv;
        u32x2 o; o.x = pk2(v[0], v[1]); o.y = pk2(v[2], v[3]); *(u32x2*)(CKVN + (size_t)t * KVR + 4 * c.lane) = o;
    }
}

__device__ __forceinline__ int idx_base(int qt) { const int a = qt >> 2, b = qt & 3; return (a + 1) * (2 * a + b); }
__device__ __forceinline__ void phase_idx_scores(KA a, const Ctx& c) {
    unsigned char* ws = a.ws; const bf16_t* QIDX = (const bf16_t*)(ws + WU_QIDX); const bf16_t* KIDX = (const bf16_t*)(ws + WU_KIDX); const float* WIDX = (const float*)(ws + WS_WIDX);
    _Float16* SC = (_Float16*)(ws + WU_SC);
    LAS float* WL = (LAS float*)(c.lds + 65536) + c.wave * 64;
    constexpr int NIT = 8320;
    const int L0 = (int)((long)NIT * c.vcu / c.G), L1 = (int)((long)NIT * (c.vcu + 1) / c.G);
    if (L0 >= L1) return;
    int qt = 0; while (idx_base(qt + 1) <= L0) ++qt;
    int kt = L0 - idx_base(qt), cur_qt = -1;
    const int lane = c.lane, r = lane & 31, hk = lane >> 5, rq = (r >> 2) & 1, head = (r & 3) + 4 * (r >> 3);
    bf16x8 qa[2][8];
    u32x4 st[4];
#define IDX_LOAD(KT_) do { _Pragma("unroll") for (int i = 0; i < 4; ++i) { const int id = c.tid + 512 * i; st[i] = *(const u32x4*)(KIDX + (size_t)(128 * (KT_) + (id >> 4)) * 128 + (id & 15) * 8); } } while (0)
#define IDX_WRITE(BUF_) do { _Pragma("unroll") for (int i = 0; i < 4; ++i) { const int id = c.tid + 512 * i, key = id >> 4, ch = id & 15; \
        *(LAS u32x4*)(c.lds + (BUF_) * 32768 + key * 256 + ((ch ^ ((key >> 2) & 15)) << 4)) = st[i]; } } while (0)
    IDX_LOAD(kt); IDX_WRITE(0);
    for (int L = L0; L < L1; ++L) {
        const int cur = (L - L0) & 1;
        if (qt != cur_qt) {
            cur_qt = qt;
#pragma unroll
            for (int rt = 0; rt < 2; ++rt) { const bf16_t* p = QIDX + (size_t)(32 * qt + 4 * c.wave + 2 * rt + rq) * 2048 + head * 128 + 8 * hk;
#pragma unroll
                for (int ks = 0; ks < 8; ++ks) qa[rt][ks] = *(const bf16x8*)(p + 16 * ks); }
            WL[lane] = WIDX[(size_t)(32 * qt + 4 * c.wave + (lane >> 4)) * 16 + (lane & 15)];
        }
        __syncthreads();
        int nqt = qt, nkt = kt + 1; if (nkt > (qt >> 2)) { nqt = qt + 1; nkt = 0; }
        const bool more = L + 1 < L1;
        if (more) IDX_LOAD(nkt);
        LAS unsigned char* KT = c.lds + cur * 32768;
        float sa0 = 0.f, sa1 = 0.f, sa2 = 0.f, sa3 = 0.f, sb0 = 0.f, sb1 = 0.f, sb2 = 0.f, sb3 = 0.f;
#pragma unroll 1
        for (int cc = 0; cc < 4; ++cc) {
            bf16x8 bfr[8];
#pragma unroll
            for (int ks = 0; ks < 8; ++ks) bfr[ks] = *(const LAS bf16x8*)(KT + (4 * r + cc) * 256 + (((ks * 2 + hk) ^ (r & 15)) << 4));
            f32x16 acc0 = {}, acc1 = {};
#pragma unroll
            for (int ks = 0; ks < 8; ++ks) { acc0 = __builtin_amdgcn_mfma_f32_32x32x16_bf16(qa[0][ks], bfr[ks], acc0, 0, 0, 0);
                acc1 = __builtin_amdgcn_mfma_f32_32x32x16_bf16(qa[1][ks], bfr[ks], acc1, 0, 0, 0); }
            float s0 = 0.f, s1 = 0.f;
            { const LAS f32x4* wp = (const LAS f32x4*)(WL + hk * 16);
#pragma unroll
              for (int q4 = 0; q4 < 4; ++q4) { const f32x4 w = wp[q4];
#pragma unroll
                  for (int e = 0; e < 4; ++e) s0 += w[e] * fmaxf(acc0[4 * q4 + e], 0.f); } }
            { const LAS f32x4* wp = (const LAS f32x4*)(WL + (2 + hk) * 16);
#pragma unroll
              for (int q4 = 0; q4 < 4; ++q4) { const f32x4 w = wp[q4];
#pragma unroll
                  for (int e = 0; e < 4; ++e) s1 += w[e] * fmaxf(acc1[4 * q4 + e], 0.f); } }
            sa0 = cc == 0 ? s0 : sa0; sa1 = cc == 1 ? s0 : sa1; sa2 = cc == 2 ? s0 : sa2; sa3 = cc == 3 ? s0 : sa3;
            sb0 = cc == 0 ? s1 : sb0; sb1 = cc == 1 ? s1 : sb1; sb2 = cc == 2 ? s1 : sb2; sb3 = cc == 3 ? s1 : sb3;
        }
        { typedef _Float16 h4 __attribute__((ext_vector_type(4)));
          h4 hv; hv[0] = (_Float16)sa0; hv[1] = (_Float16)sa1; hv[2] = (_Float16)sa2; hv[3] = (_Float16)sa3;
          *(h4*)(SC + (size_t)(32 * qt + 4 * c.wave + hk) * S + 128 * kt + 4 * r) = hv;
          hv[0] = (_Float16)sb0; hv[1] = (_Float16)sb1; hv[2] = (_Float16)sb2; hv[3] = (_Float16)sb3;
          *(h4*)(SC + (size_t)(32 * qt + 4 * c.wave + 2 + hk) * S + 128 * kt + 4 * r) = hv; }
        if (more) IDX_WRITE(cur ^ 1);
        qt = nqt; kt = nkt;
    }
#undef IDX_LOAD
#undef IDX_WRITE
    __syncthreads();
}

__device__ __forceinline__ unsigned f16key(unsigned h) { return (h & 0x8000u) ? (~h & 0xffffu) : (h | 0x8000u); }
__device__ __forceinline__ void hist_find(LAS unsigned* hist, int need, int lane, int& bsel, int& above) {
    LDS_WAIT();
    const u32x4 hv = *(const LAS u32x4*)(hist + 4 * (63 - lane));
    const int c0 = hv.w, c1 = hv.z, c2 = hv.y, c3 = hv.x, tot = c0 + c1 + c2 + c3;
    int inc = tot;
#pragma unroll
    for (int o = 1; o < 64; o <<= 1) { const int t = __shfl_up(inc, o); if (lane >= o) inc += t; }
    const int ex = inc - tot;
    const bool here = ex < need && inc >= need;
    int b = 0, ab = 0;
    if (here) { int cum = ex; if (cum + c0 >= need) { b = 255 - 4 * lane; ab = cum; } else { cum += c0; if (cum + c1 >= need) { b = 254 - 4 * lane; ab = cum; } else { cum += c1; if (cum + c2 >= need) { b = 253 - 4 * lane; ab = cum; } else { cum += c2; b = 252 - 4 * lane; ab = cum; } } } }
    const unsigned long long m = __ballot(here); const int src = m ? __builtin_ctzll(m) : 0;
    bsel = __shfl(b, src); above = __shfl(ab, src);
}
typedef short s16x4 __attribute__((ext_vector_type(4)));
__device__ __forceinline__ f32x4 mfma16(bf16x8 a_, bf16x8 b_, f32x4 c_) { return __builtin_amdgcn_mfma_f32_16x16x32_bf16(a_, b_, c_, 0, 0, 0); }
__device__ __forceinline__ void phase_dsa_attn(KA a, const Ctx& c) {
    unsigned char* ws = a.ws; const unsigned short* SC = (const unsigned short*)(ws + WU_SC); const bf16_t* CKVN = (const bf16_t*)(ws + WU_CKVN);
    const bf16_t* QLAT = (const bf16_t*)(ws + WU_QLAT); bf16_t* OLAT = (bf16_t*)(ws + WU_OLAT);
    LAS unsigned char* wl = c.lds + c.wave * 18432;
    LAS unsigned* hist = (LAS unsigned*)wl; LAS unsigned short* sel = (LAS unsigned short*)(wl + 1024); LAS unsigned char* kvl = wl + 2048;
    const int lane = c.lane, n16 = lane & 15, kq = lane >> 4;
    for (int t = c.gw; t < S; t += c.NGW) {
        const int nvalid = t + 1; int kk;
        if (nvalid <= 256) {
            kk = nvalid;
#pragma unroll
            for (int i = 0; i < 4; ++i) { const int k = lane + 64 * i; sel[k] = (unsigned short)(k < nvalid ? k : 0); }
        } else {
            kk = 256;
            const int lastc = t >> 3, nj = (t >> 9) + 1;
            unsigned zz = 0u; asm volatile("" : "+v"(zz));
            *(LAS u32x4*)(hist + 4 * lane) = (u32x4){zz, zz, zz, zz}; LDS_WAIT();
#pragma unroll 2
            for (int j = 0; j < nj; ++j) { const int ci = j * 64 + lane, cl = ci < lastc ? ci : lastc, s0 = ci * 8;
                u32x4 w = *(const u32x4*)(SC + (size_t)t * S + (size_t)cl * 8);
#pragma unroll
                for (int e = 0; e < 4; ++e) { unsigned k0 = f16key(w[e] & 0xffffu), k1 = f16key(w[e] >> 16);
                    k0 = (s0 + 2 * e > t) ? 0u : k0; k1 = (s0 + 2 * e + 1 > t) ? 0u : k1; w[e] = k0 | (k1 << 16);
                    __hip_atomic_fetch_add(hist + (k0 >> 8), 1u, __ATOMIC_RELAXED, __HIP_MEMORY_SCOPE_WORKGROUP);
                    __hip_atomic_fetch_add(hist + (k1 >> 8), 1u, __ATOMIC_RELAXED, __HIP_MEMORY_SCOPE_WORKGROUP); }
                *(LAS u32x4*)(kvl + ci * 16) = w; }
            int b1, above1; hist_find(hist, 256, lane, b1, above1);
            *(LAS u32x4*)(hist + 4 * lane) = (u32x4){zz, zz, zz, zz}; LDS_WAIT();
#pragma unroll 2
            for (int j = 0; j < nj; ++j) { const u32x4 w = *(const LAS u32x4*)(kvl + (j * 64 + lane) * 16);
#pragma unroll
                for (int e = 0; e < 4; ++e) {
                    if ((int)((w[e] >> 8) & 0xff) == b1) __hip_atomic_fetch_add(hist + (w[e] & 0xff), 1u, __ATOMIC_RELAXED, __HIP_MEMORY_SCOPE_WORKGROUP);
                    if ((int)(w[e] >> 24) == b1) __hip_atomic_fetch_add(hist + ((w[e] >> 16) & 0xff), 1u, __ATOMIC_RELAXED, __HIP_MEMORY_SCOPE_WORKGROUP); } }
            int b2, above2; hist_find(hist, 256 - above1, lane, b2, above2);
            const unsigned T = ((unsigned)b1 << 8) | (unsigned)b2; const int need_eq = 256 - above1 - above2;
            int cnt = 0, eqc = 0;
#pragma unroll 1
            for (int j = 0; j < nj; ++j) { const u32x4 w = *(const LAS u32x4*)(kvl + (j * 64 + lane) * 16);
#pragma unroll
                for (int e = 0; e < 8; ++e) { const unsigned k = (w[e >> 1] >> ((e & 1) * 16)) & 0xffffu;
                    const bool gt = k > T, eq = k == T;
                    const unsigned long long be = __ballot(eq);
                    const int eqrank = eqc + __builtin_amdgcn_mbcnt_hi((unsigned)(be >> 32), __builtin_amdgcn_mbcnt_lo((unsigned)be, 0));
                    const bool take = gt || (eq && eqrank < need_eq);
                    const unsigned long long bt = __ballot(take);
                    const int pos = cnt + __builtin_amdgcn_mbcnt_hi((unsigned)(bt >> 32), __builtin_amdgcn_mbcnt_lo((unsigned)bt, 0));
                    if (take) sel[pos] = (unsigned short)((j * 64 + lane) * 8 + e);
                    cnt += __builtin_popcountll(bt); eqc += __builtin_popcountll(be); } }
        }
        LDS_WAIT(); __builtin_amdgcn_sched_barrier(0);
        bf16x8 qf[8];
        { const bf16_t* qrow = QLAT + (size_t)t * 4096 + n16 * KVR + 8 * kq;
#pragma unroll
          for (int ks = 0; ks < 8; ++ks) qf[ks] = *(const bf16x8*)(qrow + 32 * ks); }
        f32x4 oacc[16];
#pragma unroll
        for (int ct = 0; ct < 16; ++ct) oacc[ct] = (f32x4){0.f, 0.f, 0.f, 0.f};
        float m_run = -1.0e30f, l_run = 0.f;
        const float slope = __builtin_amdgcn_exp2f(-0.5f * (float)(n16 + 1));
        const int nch = (kk + 31) >> 5;
        const int trq = n16 >> 2, trp = n16 & 3, trrow = 4 * kq + trq;
        for (int ch = 0; ch < nch; ++ch) {
#pragma unroll
            for (int hf = 0; hf < 2; ++hf) {
                u32x4 stg[8];
#pragma unroll
                for (int i = 0; i < 8; ++i) { const int row = 16 * hf + 2 * i + (lane >> 5), kidx = ch * 32 + row; const int sk = sel[kidx < kk ? kidx : 0];
                    stg[i] = *(const u32x4*)(CKVN + (size_t)sk * KVR + (lane & 31) * 8); }
#pragma unroll
                for (int i = 0; i < 8; ++i) { const int row = 16 * hf + 2 * i + (lane >> 5), cch = lane & 31;
                    *(LAS u32x4*)(kvl + row * 512 + (((cch & 16) | ((cch & 15) ^ (row & 15))) << 4)) = stg[i]; }
                __builtin_amdgcn_sched_barrier(0);
            }
            LDS_WAIT();
            f32x4 s0 = (f32x4){0.f, 0.f, 0.f, 0.f}, s1 = (f32x4){0.f, 0.f, 0.f, 0.f};
#pragma unroll
            for (int ks = 0; ks < 8; ++ks) { const int chunk = 4 * ks + kq, sw = ((chunk & 16) | ((chunk & 15) ^ n16)) << 4;
                const bf16x8 a0 = *(const LAS bf16x8*)(kvl + n16 * 512 + sw), a1 = *(const LAS bf16x8*)(kvl + (16 + n16) * 512 + sw);
                s0 = mfma16(a0, qf[ks], s0); s1 = mfma16(a1, qf[ks], s1); }
            float mx = -1.0e30f;
#pragma unroll
            for (int r = 0; r < 4; ++r) { const int k0 = ch * 32 + 4 * kq + r, k1 = k0 + 16;
                const int sk0 = sel[k0 < kk ? k0 : 0], sk1 = sel[k1 < kk ? k1 : 0];
                s0[r] = k0 < kk ? s0[r] - slope * (float)(t - sk0) : -1.0e30f; s1[r] = k1 < kk ? s1[r] - slope * (float)(t - sk1) : -1.0e30f;
                mx = fmaxf(mx, fmaxf(s0[r], s1[r])); }
            mx = fmaxf(mx, __shfl_xor(mx, 16)); mx = fmaxf(mx, __shfl_xor(mx, 32));
            const float m_new = fmaxf(m_run, mx), alpha = __builtin_amdgcn_exp2f((m_run - m_new) * LOG2E); m_run = m_new;
            float ps = 0.f;
#pragma unroll
            for (int r = 0; r < 4; ++r) { s0[r] = __builtin_amdgcn_exp2f((s0[r] - m_new) * LOG2E); s1[r] = __builtin_amdgcn_exp2f((s1[r] - m_new) * LOG2E); ps += s0[r] + s1[r]; }
            l_run = l_run * alpha + ps;
#pragma unroll
            for (int ct = 0; ct < 16; ++ct) oacc[ct] *= alpha;
            u32x4 pw; pw.x = cvt_pk_bf16(s0[0], s0[1]); pw.y = cvt_pk_bf16(s0[2], s0[3]); pw.z = cvt_pk_bf16(s1[0], s1[1]); pw.w = cvt_pk_bf16(s1[2], s1[3]);
            const bf16x8 pb = __builtin_bit_cast(bf16x8, pw);
#pragma unroll
            for (int ct = 0; ct < 16; ++ct) { const int chunk = 2 * ct + (trp >> 1), sw = (((chunk & 16) | ((chunk & 15) ^ (trrow & 15))) << 4) + 8 * (trp & 1);
                const s16x4 t0 = __builtin_amdgcn_ds_read_tr16_b64_v4i16((LAS s16x4*)(kvl + trrow * 512 + sw));
                const s16x4 t1 = __builtin_amdgcn_ds_read_tr16_b64_v4i16((LAS s16x4*)(kvl + (16 + trrow) * 512 + sw));
                const bf16x8 a2 = (bf16x8){t0[0], t0[1], t0[2], t0[3], t1[0], t1[1], t1[2], t1[3]};
                oacc[ct] = mfma16(a2, pb, oacc[ct]); }
            LDS_WAIT();
        }
        float lt = l_run; lt += __shfl_xor(lt, 16); lt += __shfl_xor(lt, 32);
        const float inv = 1.0f / lt;
#pragma unroll
        for (int ct = 0; ct < 16; ++ct) { const f32x4 o = oacc[ct] * inv; u32x2 w; w.x = cvt_pk_bf16(o[0], o[1]); w.y = cvt_pk_bf16(o[2], o[3]);
            *(u32x2*)(OLAT + (size_t)t * 4096 + n16 * KVR + 16 * ct + 4 * kq) = w; }
    }
}


__device__ __forceinline__ void phase_moba_gate(KA a, const Ctx& c, int j) {
    unsigned char* ws = a.ws; const bf16_t* Q = (const bf16_t*)(ws + WU_Q); const float* KMEAN = (const float*)(ws + WS_KMEAN) + (size_t)j * NH * 32 * HD;
    int* CNT = (int*)(ws + WS_CNT) + j * NH * 32; unsigned short* LIST = (unsigned short*)(ws + WU_LIST);
    LAS float* km = (LAS float*)c.lds;
    const int lane = c.lane;
    for (int it0 = c.vcu * 8; it0 < 2048; it0 += c.G * 8) {
        const int h = it0 >> 7;
        __syncthreads();
        for (int i = c.tid; i < 32 * 128 / 4; i += 512) *(LAS f32x4*)(km + 4 * i) = *(const f32x4*)(KMEAN + (size_t)h * 32 * HD + 4 * i);
        __syncthreads();
        const int g = (it0 & 127) + c.wave, t = 64 * g + lane, own = g >> 2;
        float qf[128];
        { const u32x4* qp4 = (const u32x4*)(Q + (size_t)t * D + h * HD);
#pragma unroll
          for (int i = 0; i < 16; ++i) { const u32x4 v = qp4[i]; qf[8 * i] = bf_lo(v.x); qf[8 * i + 1] = bf_hi(v.x); qf[8 * i + 2] = bf_lo(v.y); qf[8 * i + 3] = bf_hi(v.y);
              qf[8 * i + 4] = bf_lo(v.z); qf[8 * i + 5] = bf_hi(v.z); qf[8 * i + 6] = bf_lo(v.w); qf[8 * i + 7] = bf_hi(v.w); } }
        float v0 = -3.0e38f, v1 = -3.0e38f, v2 = -3.0e38f; int i0 = -1, i1 = -1, i2 = -1;
#pragma unroll 1
        for (int n = 0; n < own; ++n) { float s0 = 0.f, s1 = 0.f, s2 = 0.f, s3 = 0.f;
#pragma unroll
            for (int i = 0; i < 32; ++i) { const f32x4 kv = *(const LAS f32x4*)(km + n * 128 + 4 * i); s0 += qf[4 * i] * kv[0]; s1 += qf[4 * i + 1] * kv[1]; s2 += qf[4 * i + 2] * kv[2]; s3 += qf[4 * i + 3] * kv[3]; }
            const float gv = (s0 + s1) + (s2 + s3);
            if (gv > v0) { v2 = v1; i2 = i1; v1 = v0; i1 = i0; v0 = gv; i0 = n; } else if (gv > v1) { v2 = v1; i2 = i1; v1 = gv; i1 = n; } else if (gv > v2) { v2 = gv; i2 = n; } }
#pragma unroll 1
        for (int n = 0; n < own; ++n) { const int rk = (i0 == n) ? 0 : ((i1 == n) ? 1 : ((i2 == n) ? 2 : -1));
            const unsigned long long m = __ballot(rk >= 0);
            if (m) { int base = 0; const int first = __builtin_ctzll(m);
                if (lane == first) base = atomicAdd(CNT + h * 32 + n, (int)__builtin_popcountll(m));
                base = __shfl(base, first);
                const int pos = base + __builtin_amdgcn_mbcnt_hi((unsigned)(m >> 32), __builtin_amdgcn_mbcnt_lo((unsigned)m, 0));
                if (rk >= 0) LIST[((size_t)h * 32 + n) * 8192 + pos] = (unsigned short)(t | (rk << 13)); } }
    }
    __syncthreads();
}

namespace mat {
constexpr int KVBLK = 64, QBLK = 32;
constexpr float C2 = QK_SCALE * LOG2E;
constexpr float THR = 8.f;
constexpr size_t SHM_V = KVBLK * HD * 2, SHM_K = KVBLK * HD * 2;
constexpr int OFF_V = 0, OFF_K = 2 * SHM_V, OFF_WS = OFF_K + 2 * SHM_K  , OFF_TQ = OFF_WS + 8 * 256  , OFF_PFX = OFF_TQ + 8 * 128  ,
              OFF_OST = 70 * 1024  , LDS_END = OFF_OST + 8 * 8192;
static_assert(OFF_PFX + 516 * 4 <= OFF_OST && LDS_END <= LDS_BYTES, "moba attention LDS map");
typedef short s16x4 __attribute__((ext_vector_type(4)));
#define KSWZ(row, colB) ((row) * 256 + ((colB) ^ (((row) & 7) << 4)))
#define SBAR() __builtin_amdgcn_sched_barrier(0)
__device__ __forceinline__ int crow(int r, int hi) { return (r & 3) + 8 * (r >> 2) + 4 * hi; }
__device__ __forceinline__ void partialSM(f32x16& p0, f32x16& p1, float& m_reg, float& mn, float& alpha) {
  float pmax = p0[0];
#pragma unroll
  for (int r = 1; r < 16; ++r) pmax = fmaxf(pmax, p0[r]);
#pragma unroll
  for (int r = 0; r < 16; ++r) pmax = fmaxf(pmax, p1[r]);
  { auto rr = __builtin_amdgcn_permlane32_swap(__float_as_uint(pmax), __float_as_uint(pmax), false, false);
    pmax = fmaxf(__uint_as_float(rr[0]), __uint_as_float(rr[1])); }
  if (__builtin_expect(__all(pmax - m_reg <= THR / QK_SCALE), 1)) { mn = m_reg; alpha = 1.f; }
  else { mn = fmaxf(m_reg, pmax); alpha = __builtin_amdgcn_exp2f((m_reg - mn) * C2); m_reg = mn; }
  const float mnC = -mn * C2;
#pragma unroll
  for (int r = 0; r < 16; ++r) p0[r] = fmaf(p0[r], C2, mnC);
#pragma unroll
  for (int r = 0; r < 16; ++r) p1[r] = fmaf(p1[r], C2, mnC);
#pragma unroll
  for (int r = 0; r < 16; ++r) p0[r] = __builtin_amdgcn_exp2f(p0[r]);
}
__device__ __forceinline__ void finishSM(f32x16& p0, f32x16& p1, float alpha, float& l_reg, bf16x8& pa0, bf16x8& pa1, bf16x8& pa2, bf16x8& pa3) {
#pragma unroll
  for (int r = 0; r < 16; ++r) p1[r] = __builtin_amdgcn_exp2f(p1[r]);
  float ps = 0;
#pragma unroll
  for (int r = 0; r < 16; ++r) ps += p0[r];
#pragma unroll
  for (int r = 0; r < 16; ++r) ps += p1[r];
  { auto rr = __builtin_amdgcn_permlane32_swap(__float_as_uint(ps), __float_as_uint(ps), false, false);
    ps = __uint_as_float(rr[0]) + __uint_as_float(rr[1]); }
  l_reg = l_reg * alpha + ps;
#define PK4(P, BASE, OUT) do { unsigned a0 = cvt_pk_bf16(P[BASE + 0], P[BASE + 1]), a1 = cvt_pk_bf16(P[BASE + 2], P[BASE + 3]);   \
    unsigned b0 = cvt_pk_bf16(P[BASE + 4], P[BASE + 5]), b1 = cvt_pk_bf16(P[BASE + 6], P[BASE + 7]);                              \
    auto r0 = __builtin_amdgcn_permlane32_swap(a0, b0, false, false); auto r1 = __builtin_amdgcn_permlane32_swap(a1, b1, false, false); \
    u32x4 w = {r0[0], r1[0], r0[1], r1[1]}; OUT = __builtin_bit_cast(bf16x8, w); } while (0)
  PK4(p0, 0, pa0); PK4(p0, 8, pa1); PK4(p1, 0, pa2); PK4(p1, 8, pa3);
#undef PK4
}
template <bool CAUSAL>
__device__ __forceinline__ void qkt(f32x16& p0, f32x16& p1, const LAS unsigned char* Ks, const bf16x8* qr, int r32, int hi, float b0, float bs, int kpos0, int tq) {
#pragma unroll
  for (int r = 0; r < 16; ++r) { const float bb = b0 + bs * (float)((r & 3) + 8 * (r >> 2)); p0[r] = bb; p1[r] = bb + 32.f * bs; }
#pragma unroll
  for (int d0 = 0; d0 < 8; ++d0) { const int cb = (d0 * 16 + hi * 8) * 2;
    const bf16x8 k0 = *(const LAS bf16x8*)(Ks + KSWZ(r32, cb));
    const bf16x8 k1 = *(const LAS bf16x8*)(Ks + KSWZ(32 + r32, cb));
    p0 = __builtin_amdgcn_mfma_f32_32x32x16_bf16(k0, qr[d0], p0, 0, 0, 0);
    p1 = __builtin_amdgcn_mfma_f32_32x32x16_bf16(k1, qr[d0], p1, 0, 0, 0); }
  if (CAUSAL) {
#pragma unroll
    for (int r = 0; r < 16; ++r) { const int kp = kpos0 + (r & 3) + 8 * (r >> 2); p0[r] = kp > tq ? -1.0e30f : p0[r]; p1[r] = kp + 32 > tq ? -1.0e30f : p1[r]; }
  }
}
__device__ __forceinline__ int v_st(int k, int c) { const int kk = (k & ~0xC) | ((k & 4) << 1) | ((k & 8) >> 1); return ((kk >> 3) * 4 + (c >> 5)) * 512 + ((kk & 7) * 32 + (c & 31)) * 2; }
__device__ __forceinline__ int v_rd_base(int lane) { return ((lane & 3) << 3) | (((lane >> 2) & 3) << 6) | (((lane >> 4) & 1) << 5) | (((lane >> 5) & 1) << 8); }
constexpr int v_rd_off(int d0, int ks, int half) { return d0 * 512 + ks * 4096 + half * 2048; }
template <int D0> __device__ __forceinline__ void pv_one(f32x16& od, const LAS unsigned char* vb, bf16x8 pa0, bf16x8 pa1, bf16x8 pa2, bf16x8 pa3) {
#define TR(OFF) __builtin_amdgcn_ds_read_tr16_b64_v4i16((LAS s16x4*)(vb + (OFF)))
  const s16x4 l0 = TR(v_rd_off(D0, 0, 0)), h0 = TR(v_rd_off(D0, 0, 1)), l1 = TR(v_rd_off(D0, 1, 0)), h1 = TR(v_rd_off(D0, 1, 1));
  const s16x4 l2 = TR(v_rd_off(D0, 2, 0)), h2 = TR(v_rd_off(D0, 2, 1)), l3 = TR(v_rd_off(D0, 3, 0)), h3 = TR(v_rd_off(D0, 3, 1));
#undef TR
#define PK(L, H) (bf16x8){L[0], L[1], L[2], L[3], H[0], H[1], H[2], H[3]}
  od = __builtin_amdgcn_mfma_f32_32x32x16_bf16(pa0, PK(l0, h0), od, 0, 0, 0);
  od = __builtin_amdgcn_mfma_f32_32x32x16_bf16(pa1, PK(l1, h1), od, 0, 0, 0);
  od = __builtin_amdgcn_mfma_f32_32x32x16_bf16(pa2, PK(l2, h2), od, 0, 0, 0);
  od = __builtin_amdgcn_mfma_f32_32x32x16_bf16(pa3, PK(l3, h3), od, 0, 0, 0);
#undef PK
}
__device__ __forceinline__ void pv_d0(f32x16* o, const LAS unsigned char* vb, bf16x8 pa0, bf16x8 pa1, bf16x8 pa2, bf16x8 pa3) {
  pv_one<0>(o[0], vb, pa0, pa1, pa2, pa3); pv_one<1>(o[1], vb, pa0, pa1, pa2, pa3); pv_one<2>(o[2], vb, pa0, pa1, pa2, pa3); pv_one<3>(o[3], vb, pa0, pa1, pa2, pa3);
}

template <bool CAUSAL>
__device__ __forceinline__ void item_body(const bf16_t* __restrict__ Q, const bf16_t* __restrict__ Kh, const bf16_t* __restrict__ Vh, bf16_t* __restrict__ OPART, float* __restrict__ ML,
                                          int h, int n, unsigned ent, LAS unsigned char* lds, int tid) {
  const int wid = tid >> 6, lane = tid & 63, r32 = lane & 31, hi = lane >> 5;
  LAS unsigned char* V_lds = lds + OFF_V; LAS unsigned char* K_lds = lds + OFF_K;
  LAS float* wsf = (LAS float*)(lds + OFF_WS) + wid * 64; LAS float* li_l = wsf; LAS float* al_l = wsf + 32;
  LAS unsigned* tq_l = (LAS unsigned*)(lds + OFF_TQ) + wid * 32;
  const int tq = (int)(ent & 8191u);
  float m_reg = -1e30f, l_reg = 0; f32x16 o[4] = {}; bf16x8 qr[8];
  { const bf16_t* Qw = Q + (size_t)tq * D + h * HD + hi * 8;
#pragma unroll
    for (int d0 = 0; d0 < 8; ++d0) qr[d0] = *(const bf16x8*)(Qw + d0 * 16); }
  const float bs = __builtin_amdgcn_exp2f(-0.5f * (float)(h + 1)) * (1.0f / QK_SCALE);
  const int kp0 = n * 256 + 4 * hi;
  const float bq = bs * (float)(kp0 - tq);
  const int sr = tid >> 4, sc = (tid & 15) * 8, vst0 = v_st(sr, sc), vst1 = v_st(32 + sr, sc);
  const LAS unsigned char* vb0 = V_lds + v_rd_base(lane);
  bf16x8 vs0, vs1, ks0, ks1;
#define SLOAD(k0) do { vs0 = *(const bf16x8*)(Vh + (size_t)((k0) + sr) * D + sc); vs1 = *(const bf16x8*)(Vh + (size_t)((k0) + 32 + sr) * D + sc); \
    ks0 = *(const bf16x8*)(Kh + (size_t)((k0) + sr) * D + sc); ks1 = *(const bf16x8*)(Kh + (size_t)((k0) + 32 + sr) * D + sc); } while (0)
#define SWRITE(b) do { *(LAS bf16x8*)(V_lds + (b) * SHM_V + vst0) = vs0; *(LAS bf16x8*)(V_lds + (b) * SHM_V + vst1) = vs1; const int kc = sc * 2; \
    *(LAS bf16x8*)(K_lds + (b) * SHM_K + KSWZ(sr, kc)) = ks0; *(LAS bf16x8*)(K_lds + (b) * SHM_K + KSWZ(32 + sr, kc)) = ks1; } while (0)
#define SWAIT() asm volatile("s_waitcnt vmcnt(0)" ::: "memory")
#define RESC(al) do { if (__any((al) < 1.f)) { if (hi == 0) al_l[r32] = (al); asm volatile("s_waitcnt lgkmcnt(0)" ::: "memory"); \
    _Pragma("unroll") for (int d = 0; d < 4; ++d) _Pragma("unroll") for (int r = 0; r < 16; ++r) o[d][r] *= al_l[crow(r, hi)]; } } while (0)
  f32x16 pA0, pA1, pB0, pB1; float mnA, mnB, alA, alB; bf16x8 pa0, pa1, pa2, pa3;
  SLOAD(0); SWAIT(); SWRITE(0); __syncthreads();
  qkt<CAUSAL>(pA0, pA1, K_lds, qr, r32, hi, bq, bs, kp0, tq); partialSM(pA0, pA1, m_reg, mnA, alA);
  SLOAD(KVBLK); SWAIT(); SWRITE(1); __syncthreads();
  {
    SBAR(); qkt<CAUSAL>(pB0, pB1, K_lds + SHM_K, qr, r32, hi, bq + 64.f * bs, bs, kp0 + 64, tq);
    finishSM(pA0, pA1, alA, l_reg, pa0, pa1, pa2, pa3); SBAR();
    SLOAD(2 * KVBLK); SBAR();
    pv_d0(o, vb0, pa0, pa1, pa2, pa3); partialSM(pB0, pB1, m_reg, mnB, alB);
    __syncthreads(); SWAIT(); SWRITE(0);
    RESC(alB); __syncthreads();
    SBAR(); qkt<CAUSAL>(pA0, pA1, K_lds, qr, r32, hi, bq + 128.f * bs, bs, kp0 + 128, tq);
    finishSM(pB0, pB1, alB, l_reg, pa0, pa1, pa2, pa3); SBAR();
    SLOAD(3 * KVBLK); SBAR();
    pv_d0(o, vb0 + SHM_V, pa0, pa1, pa2, pa3); partialSM(pA0, pA1, m_reg, mnA, alA);
    __syncthreads(); SWAIT(); SWRITE(1);
    RESC(alA); __syncthreads();
  }
  SBAR(); qkt<CAUSAL>(pB0, pB1, K_lds + SHM_K, qr, r32, hi, bq + 192.f * bs, bs, kp0 + 192, tq);
  finishSM(pA0, pA1, alA, l_reg, pa0, pa1, pa2, pa3); SBAR();
  pv_d0(o, vb0, pa0, pa1, pa2, pa3); partialSM(pB0, pB1, m_reg, mnB, alB);
  __syncthreads(); RESC(alB);
  finishSM(pB0, pB1, alB, l_reg, pa0, pa1, pa2, pa3); SBAR();
  pv_d0(o, vb0 + SHM_V, pa0, pa1, pa2, pa3);
  if (hi == 0) { li_l[r32] = l_reg; tq_l[r32] = ent; }
  asm volatile("s_waitcnt lgkmcnt(0)" ::: "memory");
  LAS unsigned short* ost = (LAS unsigned short*)(lds + OFF_OST + wid * 8192);
#pragma unroll
  for (int r = 0; r < 16; ++r) { const int orow = crow(r, hi); const float rl = __builtin_amdgcn_rcpf(li_l[orow]);
#pragma unroll
    for (int d0 = 0; d0 < 4; ++d0) ost[orow * 128 + d0 * 32 + r32] = (unsigned short)f2bf(o[d0][r] * rl); }
  asm volatile("s_waitcnt lgkmcnt(0)" ::: "memory");
#pragma unroll
  for (int i = 0; i < 8; ++i) { const int row = 4 * i + (lane >> 4), ch = lane & 15; const unsigned e = tq_l[row];
    const u32x4 v = *(const LAS u32x4*)((LAS unsigned char*)ost + row * 256 + ch * 16);
    if (!(e & 0x8000u)) *(u32x4*)(OPART + ((size_t)((e >> 13) & 3u) * S + (e & 8191u)) * D + h * HD + ch * 8) = v; }
  if (hi == 0 && !(ent & 0x8000u)) { float* p = ML + (((size_t)((ent >> 13) & 3u) * S + tq) * NH + h) * 2; p[0] = m_reg * C2; p[1] = l_reg; }
  __syncthreads();
#undef SLOAD
#undef SWRITE
#undef SWAIT
#undef RESC
}
#undef KSWZ
#undef SBAR
}

__device__ __forceinline__ void phase_moba_attn(KA a, const Ctx& c, int j) {
    unsigned char* ws = a.ws; const bf16_t* Q = (const bf16_t*)(ws + WU_Q); const bf16_t* Kb = (const bf16_t*)(ws + WU_K); const bf16_t* V = (const bf16_t*)(ws + WU_V);
    bf16_t* OPART = (bf16_t*)(ws + WU_OPART); float* ML = (float*)(ws + WU_ML); const int* CNT = (const int*)(ws + WS_CNT) + j * NH * 32; const unsigned short* LIST = (const unsigned short*)(ws + WU_LIST);
    LAS int* pfx = (LAS int*)(c.lds + mat::OFF_PFX);
    if (c.tid == 0) { int run = 0; for (int i = 0; i < 512; ++i) { pfx[i] = run; run += 1 + ((CNT[i] + 255) >> 8); } pfx[512] = run; }
    __syncthreads();
    const int total = __builtin_amdgcn_readfirstlane(pfx[512]);
    for (int it = c.vcu; it < total; it += c.G) {
        int lo = 0, hi_ = 511;
        while (lo < hi_) { const int mid = (lo + hi_ + 1) >> 1; if (pfx[mid] <= it) lo = mid; else hi_ = mid - 1; }
        const int pair = lo, h = pair >> 5, n = pair & 31, tile = it - pfx[pair];
        const bf16_t* Kh = Kb + (size_t)(n * 256) * D + h * HD; const bf16_t* Vh = V + (size_t)(n * 256) * D + h * HD;
        int tidl = c.tid; asm volatile("" : "+v"(tidl));
        const int e = ((tidl >> 6) << 5) + (tidl & 31);
        if (tile == 0) { const unsigned ent = (unsigned)(n * 256 + e) | (3u << 13);
            mat::item_body<true>(Q, Kh, Vh, OPART, ML, h, n, ent, c.lds, tidl);
        } else { const int cnt = CNT[pair], idx = (tile - 1) * 256 + e; unsigned ent = LIST[(size_t)pair * 8192 + (idx < cnt ? idx : 0)]; if (idx >= cnt) ent |= 0x8000u;
            mat::item_body<false>(Q, Kh, Vh, OPART, ML, h, n, ent, c.lds, tidl); }
    }
    __syncthreads();
}

__device__ __forceinline__ void phase_moba_combine(KA a, const Ctx& c) {
    unsigned char* ws = a.ws; const bf16_t* OPART = (const bf16_t*)(ws + WU_OPART); const float* ML = (const float*)(ws + WU_ML);
    const bf16_t* SG = (const bf16_t*)(ws + WS_SG); bf16_t* GACT = (bf16_t*)(ws + WS_GACT);
    const int lane = c.lane;
    for (int it = c.gw; it < S * 4; it += c.NGW) {
        const int t = it >> 2, h = (it & 3) * 4 + (lane >> 4), dq = lane & 15, own = t >> 8, np = own < 3 ? own : 3;
        float m[4], l[4]; float M = -3.0e38f;
#pragma unroll
        for (int sl = 0; sl < 4; ++sl) { const bool ok = sl == 3 || sl < np; const float* p = ML + (((size_t)sl * S + t) * NH + h) * 2; m[sl] = ok ? p[0] : -3.0e38f; l[sl] = ok ? p[1] : 0.f; M = fmaxf(M, m[sl]); }
        float wsum = 0.f; float o[8];
#pragma unroll
        for (int e = 0; e < 8; ++e) o[e] = 0.f;
#pragma unroll
        for (int sl = 0; sl < 4; ++sl) { const bool ok = sl == 3 || sl < np; const float w = ok ? l[sl] * __builtin_amdgcn_exp2f(m[sl] - M) : 0.f; wsum += w;
            u32x4 v = (u32x4){0u, 0u, 0u, 0u}; if (ok) v = *(const u32x4*)(OPART + ((size_t)sl * S + t) * D + h * HD + dq * 8);
            o[0] += w * bf_lo(v.x); o[1] += w * bf_hi(v.x); o[2] += w * bf_lo(v.y); o[3] += w * bf_hi(v.y); o[4] += w * bf_lo(v.z); o[5] += w * bf_hi(v.z); o[6] += w * bf_lo(v.w); o[7] += w * bf_hi(v.w); }
        const float inv = 1.0f / wsum; const size_t off = (size_t)t * D + h * HD + dq * 8; const u32x4 gv = *(const u32x4*)(SG + off);
        u32x4 w; w.x = pk2(o[0] * inv * bf_lo(gv.x), o[1] * inv * bf_hi(gv.x)); w.y = pk2(o[2] * inv * bf_lo(gv.y), o[3] * inv * bf_hi(gv.y));
        w.z = pk2(o[4] * inv * bf_lo(gv.z), o[5] * inv * bf_hi(gv.z)); w.w = pk2(o[6] * inv * bf_lo(gv.w), o[7] * inv * bf_hi(gv.w));
        *(u32x4*)(GACT + off) = w;
    }
}

__device__ __forceinline__ float bfu(bf16_t v) { return __builtin_bit_cast(float, (unsigned)v << 16); }
struct ChkAcc { LAS float* ss; LAS unsigned* mx; LAS unsigned* cnt; };
__device__ __forceinline__ void chk_add(const ChkAcc& A, float naive, float mine) {
    atomicAdd((float*)A.ss, naive * naive); atomicMax((unsigned*)A.mx, __builtin_bit_cast(unsigned, fabsf(naive - mine))); atomicAdd((unsigned*)A.cnt, 1u);
}
__device__ __forceinline__ void chk_begin(const ChkAcc& A, int tid) { __syncthreads(); if (tid == 0) { *A.ss = 0.f; *A.mx = 0u; *A.cnt = 0u; } __syncthreads(); }
__device__ __forceinline__ void chk_end(const ChkAcc& A, int tid, float* dbg, int stage) {
    __syncthreads();
    if (tid == 0) { const float rms = sqrtf(*A.ss / fmaxf((float)*A.cnt, 1.f)) + 1e-20f; const float e = __builtin_bit_cast(float, *A.mx) / rms;
        atomicMax((unsigned*)(dbg + stage), __builtin_bit_cast(unsigned, e)); }
    __syncthreads();
}
__device__ __forceinline__ unsigned f16key_d(unsigned h) { return (h & 0x8000u) ? (~h & 0xffffu) : (h | 0x8000u); }

__device__ __forceinline__ void check_dsa(KA a, unsigned char* ws, LAS unsigned char* lds, int tid, int layer) {
    const int j = layer >> 1; float* dbg = (float*)(ws + WS_CTL + 4096) + layer * 16;
    ChkAcc A{(LAS float*)(lds + 0), (LAS unsigned*)(lds + 4), (LAS unsigned*)(lds + 8)};
    LAS float* buf = (LAS float*)(lds + 1024);
    LAS unsigned short* keys = (LAS unsigned short*)(lds + 1024 + 32768);
    LAS int* slist = (LAS int*)(lds + 1024 + 32768 + 16384);
    LAS float* lgt = (LAS float*)(lds + 1024 + 32768 + 16384 + 2048);
    const bf16_t* HB = (const bf16_t*)(ws + WS_HB); const bf16_t* CQ = (const bf16_t*)(ws + WU_CQ); const float* CKV = (const float*)(ws + WU_CKV);
    const bf16_t* CKVN = (const bf16_t*)(ws + WU_CKVN); const bf16_t* KIDX = (const bf16_t*)(ws + WU_KIDX); const float* WIDX = (const float*)(ws + WS_WIDX);
    const bf16_t* SG = (const bf16_t*)(ws + WS_SG); const bf16_t* QLAT = (const bf16_t*)(ws + WU_QLAT); const bf16_t* QIDX = (const bf16_t*)(ws + WU_QIDX);
    const unsigned short* SC = (const unsigned short*)(ws + WU_SC); const bf16_t* OLAT = (const bf16_t*)(ws + WU_OLAT); const bf16_t* GACT = (const bf16_t*)(ws + WS_GACT);
    const float* Z = (const float*)(ws + WS_Z); const float* MOD = (const float*)(ws + WS_MOD);
    const float* w_in = a.in[6] + (size_t)j * D * DSA_IN; const float* g_q = a.in[7] + j * QR; const float* g_kv = a.in[8] + j * KVR;
    const float* w_uq = a.in[9] + (size_t)j * QR * 2048; const float* w_qi = a.in[10] + (size_t)j * QR * 2048; const float* w_uk = a.in[11] + (size_t)j * NH * HD * KVR;
    const float* w_uv = a.in[12] + (size_t)j * NH * KVR * HD; const float* w_o = a.in[13] + (size_t)j * D * D;
    const float* X = layer == 0 ? a.in[0] : (const float*)(ws + WS_X1);
    for (int ti = 0; ti < 32; ++ti) {
        const int t = (int)(blockIdx.x + 256u * ti);
        chk_begin(A, tid);
        for (int n = tid; n < DSA_IN; n += 512) { float s = 0.f; for (int k = 0; k < D; ++k) s += bfu(HB[(size_t)t * D + k]) * w_in[(size_t)k * DSA_IN + n];
            float mine;
            if (n < 512) mine = bfu(CQ[(size_t)t * QR + n]); else if (n < 768) mine = CKV[(size_t)t * KVR + n - 512]; else if (n < 896) mine = bfu(KIDX[(size_t)t * 128 + n - 768]);
            else if (n < 912) { mine = WIDX[(size_t)t * 16 + n - 896]; s *= 0.25f; } else { mine = bfu(SG[(size_t)t * D + n - 912]); s = s / (1.f + expf(-s)); }
            chk_add(A, s, mine); }
        chk_end(A, tid, dbg, 1);
        chk_begin(A, tid);
        { float ss = 0.f; for (int k = 0; k < KVR; ++k) { const float v = CKV[(size_t)t * KVR + k]; ss += v * v; } const float rs = 1.f / sqrtf(ss / KVR + LN_EPS);
          for (int n = tid; n < KVR; n += 512) chk_add(A, CKV[(size_t)t * KVR + n] * rs * g_kv[n], bfu(CKVN[(size_t)t * KVR + n])); }
        chk_end(A, tid, dbg, 1);
        { float ss = 0.f; for (int k = 0; k < QR; ++k) { const float v = bfu(CQ[(size_t)t * QR + k]); ss += v * v; } const float rs = 1.f / sqrtf(ss / QR + LN_EPS);
          __syncthreads();
          for (int k = tid; k < QR; k += 512) buf[k] = bfu(CQ[(size_t)t * QR + k]) * rs * g_q[k];
          __syncthreads();
          for (int n = tid; n < 2048; n += 512) { float s = 0.f; for (int k = 0; k < QR; ++k) s += buf[k] * w_uq[(size_t)k * 2048 + n]; buf[1024 + n] = s; }
          chk_begin(A, tid);
          for (int n = tid; n < 4096; n += 512) { const int h = n >> 8, cc = n & 255; float s = 0.f; for (int d = 0; d < HD; ++d) s += buf[1024 + h * HD + d] * w_uk[((size_t)h * HD + d) * KVR + cc];
              chk_add(A, s * QK_SCALE, bfu(QLAT[(size_t)t * 4096 + n])); }
          chk_end(A, tid, dbg, 2);
          chk_begin(A, tid);
          for (int n = tid; n < 2048; n += 512) { float s = 0.f; for (int k = 0; k < QR; ++k) s += buf[k] * w_qi[(size_t)k * 2048 + n]; chk_add(A, s * QK_SCALE, bfu(QIDX[(size_t)t * 2048 + n])); }
          chk_end(A, tid, dbg, 2); }
        chk_begin(A, tid);
        for (int sidx = tid; sidx <= t; sidx += 512) { float sc = 0.f;
            for (int h = 0; h < 16; ++h) { float l = 0.f; for (int d = 0; d < 128; ++d) l += bfu(QIDX[(size_t)t * 2048 + h * 128 + d]) * bfu(KIDX[(size_t)sidx * 128 + d]); sc += WIDX[(size_t)t * 16 + h] * fmaxf(l, 0.f); }
            const unsigned short hb = SC[(size_t)t * S + sidx]; _Float16 hv = __builtin_bit_cast(_Float16, hb); chk_add(A, sc, (float)hv); }
        chk_end(A, tid, dbg, 3);
        __syncthreads();
        for (int sidx = tid; sidx < S; sidx += 512) keys[sidx] = sidx <= t ? (unsigned short)f16key_d(SC[(size_t)t * S + sidx]) : (unsigned short)0;
        if (tid == 0) slist[256] = 0;
        __syncthreads();
        const int kk = t + 1 < 256 ? t + 1 : 256;
        for (int sidx = tid; sidx <= t; sidx += 512) {
            bool selq;
            if (t + 1 <= 256) selq = true;
            else { const unsigned k0 = keys[sidx]; const int o0 = (sidx >> 9) * 512 + (sidx & 7) * 64 + ((sidx >> 3) & 63); int rank = 0;
                for (int s2 = 0; s2 <= t; ++s2) { const unsigned k2 = keys[s2]; const int o2 = (s2 >> 9) * 512 + (s2 & 7) * 64 + ((s2 >> 3) & 63); rank += (k2 > k0 || (k2 == k0 && o2 < o0)) ? 1 : 0; }
                selq = rank < 256; }
            if (selq) { const int p = atomicAdd((int*)&slist[256], 1); if (p < 256) slist[p] = sidx; } }
        __syncthreads();
        for (int idx = tid; idx < 16 * 256; idx += 512) { const int h = idx >> 8, k = idx & 255; float l = -1e30f;
            if (k < kk) { const int sk = slist[k]; float s = 0.f; for (int cc = 0; cc < KVR; ++cc) s += bfu(QLAT[(size_t)t * 4096 + h * KVR + cc]) * bfu(CKVN[(size_t)sk * KVR + cc]);
                l = s - exp2f(-0.5f * (float)(h + 1)) * (float)(t - sk); }
            lgt[idx] = l; }
        __syncthreads();
        if (tid < 16) { float m = -1e30f; for (int k = 0; k < 256; ++k) m = fmaxf(m, lgt[tid * 256 + k]); float sum = 0.f; for (int k = 0; k < 256; ++k) { const float e = lgt[tid * 256 + k] > -1e29f ? expf(lgt[tid * 256 + k] - m) : 0.f; lgt[tid * 256 + k] = e; sum += e; }
            for (int k = 0; k < 256; ++k) lgt[tid * 256 + k] /= sum; }
        chk_begin(A, tid);
        for (int n = tid; n < 4096; n += 512) { const int h = n >> 8, cc = n & 255; float s = 0.f; for (int k = 0; k < kk; ++k) s += lgt[h * 256 + k] * bfu(CKVN[(size_t)slist[k] * KVR + cc]);
            chk_add(A, s, bfu(OLAT[(size_t)t * 4096 + n])); }
        chk_end(A, tid, dbg, 5);
        chk_begin(A, tid);
        for (int n = tid; n < D; n += 512) { const int h = n >> 7, d = n & 127; float s = 0.f; for (int cc = 0; cc < KVR; ++cc) s += bfu(OLAT[(size_t)t * 4096 + h * KVR + cc]) * w_uv[((size_t)h * KVR + cc) * HD + d];
            chk_add(A, s * bfu(SG[(size_t)t * D + n]), bfu(GACT[(size_t)t * D + n])); }
        chk_end(A, tid, dbg, 6);
        chk_begin(A, tid);
        for (int n = tid; n < D; n += 512) { float s = 0.f; for (int k = 0; k < D; ++k) s += bfu(GACT[(size_t)t * D + k]) * w_o[(size_t)k * D + n];
            chk_add(A, DN_ALPHA * X[(size_t)t * D + n] + MOD[(size_t)layer * 6144 + 4096 + n] * s, Z[(size_t)t * D + n]); }
        chk_end(A, tid, dbg, 7);
    }
}
__device__ __forceinline__ void check_moba(KA a, unsigned char* ws, LAS unsigned char* lds, int tid, int layer) {
    const int j = layer >> 1; float* dbg = (float*)(ws + WS_CTL + 4096) + layer * 16;
    ChkAcc A{(LAS float*)(lds + 0), (LAS unsigned*)(lds + 4), (LAS unsigned*)(lds + 8)};
    LAS float* pbuf = (LAS float*)(lds + 1024);
    LAS int* blks = (LAS int*)(lds + 1024 + 65536);
    const bf16_t* HB = (const bf16_t*)(ws + WS_HB); const bf16_t* Q = (const bf16_t*)(ws + WU_Q); const bf16_t* Kb = (const bf16_t*)(ws + WU_K); const bf16_t* V = (const bf16_t*)(ws + WU_V);
    const bf16_t* SG = (const bf16_t*)(ws + WS_SG); const bf16_t* GACT = (const bf16_t*)(ws + WS_GACT); const float* KMEAN = (const float*)(ws + WS_KMEAN) + (size_t)j * NH * 32 * HD;
    const float* Z = (const float*)(ws + WS_Z); const float* MOD = (const float*)(ws + WS_MOD); const float* X = (const float*)(ws + WS_X1);
    const float* w_in = a.in[14] + (size_t)j * D * MOBA_IN; const float* w_o = a.in[15] + (size_t)j * D * D;
    chk_begin(A, tid);
    for (int idx = tid; idx < 4 * 128; idx += 512) { const int which = idx >> 7, d = idx & 127; const int h = (which * 5 + 1 + blockIdx.x) & 15, n = (which * 11 + 2 + blockIdx.x * 7) & 31; float s = 0.f;
        for (int r = 0; r < 256; ++r) s += bfu(Kb[(size_t)(n * 256 + r) * D + h * HD + d]); chk_add(A, s / 256.f, KMEAN[((size_t)h * 32 + n) * HD + d]); }
    chk_end(A, tid, dbg, 10);
    for (int ti = 0; ti < 32; ++ti) {
        const int t = (int)(blockIdx.x + 256u * ti), own = t >> 8;
        chk_begin(A, tid);
        for (int n = tid; n < MOBA_IN; n += 512) { float s = 0.f; for (int k = 0; k < D; ++k) s += bfu(HB[(size_t)t * D + k]) * w_in[(size_t)k * MOBA_IN + n];
            float mine; const int seg = n >> 11, cn = n & 2047;
            if (seg == 0) mine = bfu(Q[(size_t)t * D + cn]); else if (seg == 1) mine = bfu(Kb[(size_t)t * D + cn]); else if (seg == 2) mine = bfu(V[(size_t)t * D + cn]); else { mine = bfu(SG[(size_t)t * D + cn]); s = s / (1.f + expf(-s)); }
            chk_add(A, s, mine); }
        chk_end(A, tid, dbg, 9);
        __syncthreads();
        { LAS float* gg = pbuf;
          for (int idx = tid; idx < 16 * 32; idx += 512) { const int h = idx >> 5, n = idx & 31; float s = -3e38f;
              if (n < own) { s = 0.f; for (int d = 0; d < HD; ++d) s += bfu(Q[(size_t)t * D + h * HD + d]) * KMEAN[((size_t)h * 32 + n) * HD + d]; } gg[idx] = s; }
          __syncthreads();
          if (tid < 16) { const int h = tid;
              for (int r = 0; r < 3; ++r) { int best = -1; float bv = -1e38f; for (int n = 0; n < 32; ++n) if (gg[h * 32 + n] > bv) { bv = gg[h * 32 + n]; best = n; } blks[h * 4 + r] = best; if (best >= 0) gg[h * 32 + best] = -3e38f; }
              blks[h * 4 + 3] = own; } }
        __syncthreads();
        for (int idx = tid; idx < 16 * 1024; idx += 512) { const int h = idx >> 10, b = (idx >> 8) & 3, k = idx & 255; const int blk = blks[h * 4 + b]; float l = -1e30f;
            if (blk >= 0) { const int pos = blk * 256 + k; if (pos <= t) { float s = 0.f; for (int d = 0; d < HD; ++d) s += bfu(Q[(size_t)t * D + h * HD + d]) * bfu(Kb[(size_t)pos * D + h * HD + d]);
                l = s * QK_SCALE - exp2f(-0.5f * (float)(h + 1)) * (float)(t - pos); } }
            pbuf[idx] = l; }
        __syncthreads();
        if (tid < 16) { float m = -1e30f; for (int k = 0; k < 1024; ++k) m = fmaxf(m, pbuf[tid * 1024 + k]); float sum = 0.f;
            for (int k = 0; k < 1024; ++k) { const float e = pbuf[tid * 1024 + k] > -1e29f ? expf(pbuf[tid * 1024 + k] - m) : 0.f; pbuf[tid * 1024 + k] = e; sum += e; }
            for (int k = 0; k < 1024; ++k) pbuf[tid * 1024 + k] /= sum; }
        chk_begin(A, tid);
        for (int n = tid; n < D; n += 512) { const int h = n >> 7, d = n & 127; float s = 0.f;
            for (int b = 0; b < 4; ++b) { const int blk = blks[h * 4 + b]; if (blk < 0) continue; for (int k = 0; k < 256; ++k) s += pbuf[h * 1024 + b * 256 + k] * bfu(V[(size_t)(blk * 256 + k) * D + n]); }
            chk_add(A, s * bfu(SG[(size_t)t * D + n]), bfu(GACT[(size_t)t * D + n])); (void)d; }
        chk_end(A, tid, dbg, 11);
        chk_begin(A, tid);
        for (int n = tid; n < D; n += 512) { float s = 0.f; for (int k = 0; k < D; ++k) s += bfu(GACT[(size_t)t * D + k]) * w_o[(size_t)k * D + n];
            chk_add(A, DN_ALPHA * X[(size_t)t * D + n] + MOD[(size_t)layer * 6144 + 4096 + n] * s, Z[(size_t)t * D + n]); }
        chk_end(A, tid, dbg, 12);
    }
}


__device__ __forceinline__ void check_post(KA a, unsigned char* ws, LAS unsigned char* lds, int tid, int layer) {
    float* dbg = (float*)(ws + WS_CTL + 4096) + layer * 16;
    ChkAcc A{(LAS float*)(lds + 0), (LAS unsigned*)(lds + 4), (LAS unsigned*)(lds + 8)};
    LAS float* red = (LAS float*)(lds + 64);
    const float* Z = (const float*)(ws + WS_Z); const float* MOD = (const float*)(ws + WS_MOD); const bool last = layer == DEPTH - 1;
    const float* XO = last ? a.out : (const float*)(ws + WS_X1); const bf16_t* HB = (const bf16_t*)(ws + WS_HB);
    for (int ti = 0; ti < 32; ++ti) {
        const int t = (int)(blockIdx.x + 256u * ti);
        __syncthreads(); if (tid == 0) { float s = 0.f; for (int k = 0; k < D; ++k) s += Z[(size_t)t * D + k]; const float mean = s / D; float q = 0.f; for (int k = 0; k < D; ++k) { const float d = Z[(size_t)t * D + k] - mean; q += d * d; }
            red[0] = mean; red[1] = 1.f / sqrtf(q / D + LN_EPS); } __syncthreads();
        const float mean = red[0], rstd = red[1];
        if (!last) { chk_begin(A, tid);
            for (int n = tid; n < D; n += 512) { const float y = (Z[(size_t)t * D + n] - mean) * rstd * a.in[4][layer * D + n] + a.in[5][layer * D + n]; chk_add(A, y, XO[(size_t)t * D + n]); }
            chk_end(A, tid, dbg, 13);
            chk_begin(A, tid);
            for (int n = tid; n < D; n += 512) { const float y = (Z[(size_t)t * D + n] - mean) * rstd * a.in[4][layer * D + n] + a.in[5][layer * D + n];
                chk_add(A, y * (1.f + MOD[(size_t)(layer + 1) * 6144 + 2048 + n]) + MOD[(size_t)(layer + 1) * 6144 + n], bfu(HB[(size_t)t * D + n])); }
            chk_end(A, tid, dbg, 14); }
    }
    if (layer == 0 && blockIdx.x == 0) {
        chk_begin(A, tid);
        for (int idx = tid; idx < 4 * 6144; idx += 512) { const int i = idx / 6144, n = idx % 6144; float s = a.in[3][idx];
            for (int k = 0; k < D; ++k) { const float cv = a.in[1][k]; s += cv / (1.f + expf(-cv)) * a.in[2][((size_t)i * D + k) * 6144 + n]; } chk_add(A, s, MOD[idx]); }
        chk_end(A, tid, dbg, 15);
    }
}
__device__ __forceinline__ void check_h0(KA a, unsigned char* ws, LAS unsigned char* lds, int tid) {
    float* dbg = (float*)(ws + WS_CTL + 4096);
    ChkAcc A{(LAS float*)(lds + 0), (LAS unsigned*)(lds + 4), (LAS unsigned*)(lds + 8)};
    const float* MOD = (const float*)(ws + WS_MOD); const bf16_t* HB = (const bf16_t*)(ws + WS_HB);
    chk_begin(A, tid);
    for (int ti = 0; ti < 32; ++ti) { const int t = (int)(blockIdx.x + 256u * ti);
        for (int n = tid; n < D; n += 512) chk_add(A, a.in[0][(size_t)t * D + n] * (1.f + MOD[2048 + n]) + MOD[n], bfu(HB[(size_t)t * D + n])); }
    chk_end(A, tid, dbg, 8);
}


#define XB_TMO      128
#define XB_XCNT(j)  (256  + 64 * (j))
#define XB_XSUB(j)  (1280 + 64 * (j))
#define XB_XGEN(j)  (2304 + 64 * (j))
#define XB_TOP      3328
#define XB_TOPGEN   3392
#define XCD_BAR_WORDS 3456
#define XB_SPIN_CAP (1u << 20)
__device__ __forceinline__ unsigned xb_ld(unsigned* p)              { return __hip_atomic_load(p, __ATOMIC_RELAXED, __HIP_MEMORY_SCOPE_AGENT); }
__device__ __forceinline__ unsigned xb_add(unsigned* p, unsigned v) { return __hip_atomic_fetch_add(p, v, __ATOMIC_RELAXED, __HIP_MEMORY_SCOPE_AGENT); }
__device__ __forceinline__ unsigned xb_xcc_id() { return (unsigned)__builtin_amdgcn_s_getreg((3 << 11) | 20) & 0xFu; }
#define XB_SPIN(cond, bar) do { unsigned _sp = 0; while (cond) { __builtin_amdgcn_s_sleep(1); \
    if ((++_sp & 255u) == 0u) { if (xb_ld(&(bar)[XB_TMO])) break; if (_sp > XB_SPIN_CAP) { atomicAdd(&(bar)[XB_TMO], 1u); break; } } } } while (0)
struct XcdBarrier { unsigned* bar; unsigned x; volatile LAS unsigned* st; };
__device__ __forceinline__ XcdBarrier xcd_barrier_post(unsigned* bar, volatile LAS unsigned* st) {
    XcdBarrier b; b.bar = bar; b.x = xb_xcc_id(); b.st = st;
    if (threadIdx.x == 0) (void)xb_add(&bar[XB_XCNT(b.x)], 1u);
    return b;
}
__device__ __forceinline__ void xcd_barrier_complete(unsigned* bar, unsigned x, unsigned& nloc, unsigned& nx) {
    const unsigned G = gridDim.x * gridDim.y * gridDim.z;
    unsigned sum, cnt, mine, sp = 0u;
    for (;;) {
        sum = 0u; cnt = 0u; mine = 0u;
#pragma unroll
        for (unsigned j = 0; j < 16; ++j) { const unsigned c = xb_ld(&bar[XB_XCNT(j)]); sum += c; cnt += (c > 0u) ? 1u : 0u; mine = (j == x) ? c : mine; }
        if (sum == G) break;
        __builtin_amdgcn_s_sleep(1);
        if ((++sp & 255u) == 0u) { if (xb_ld(&bar[XB_TMO])) break; if (sp > XB_SPIN_CAP) { atomicAdd(&bar[XB_TMO], 1u); break; } }
    }
    nloc = mine > 0u ? mine : 1u; nx = cnt > 0u ? cnt : 1u;
}
__device__ __forceinline__ void xcd_barrier(const XcdBarrier& b) {
    asm volatile("s_waitcnt vmcnt(0)" ::: "memory");
    __syncthreads();
    if (threadIdx.x == 0) {
        unsigned* bar = b.bar;
        __builtin_amdgcn_s_waitcnt(0);
        unsigned nloc = b.st[0], nx = b.st[1];
        if (nloc == 0u) { xcd_barrier_complete(bar, b.x, nloc, nx); b.st[0] = nloc; b.st[1] = nx; }
        const unsigned old = xb_add(&bar[XB_XSUB(b.x)], 1u);
        const unsigned gen = old / nloc;
        if (old + 1u == (gen + 1u) * nloc) {
            __builtin_amdgcn_fence(__ATOMIC_RELEASE, "agent");
            asm volatile("s_waitcnt vmcnt(0)" ::: "memory");
            const unsigned og = xb_add(&bar[XB_TOP], 1u);
            const unsigned tg = og / nx;
            if (og + 1u == (tg + 1u) * nx) xb_add(&bar[XB_TOPGEN], 1u);
            else XB_SPIN(xb_ld(&bar[XB_TOPGEN]) == tg, bar);
            __builtin_amdgcn_fence(__ATOMIC_ACQUIRE, "agent");
            xb_add(&bar[XB_XGEN(b.x)], 1u);
            asm volatile("s_waitcnt vmcnt(0)" ::: "memory");
        } else {
            XB_SPIN(xb_ld(&bar[XB_XGEN(b.x)]) == gen, bar);
            __builtin_amdgcn_fence(__ATOMIC_ACQUIRE, "agent");
            asm volatile("s_waitcnt vmcnt(0)" ::: "memory");
        }
    }
    __syncthreads();
}
constexpr size_t WS_BAR = WS_CTL + 16384;

enum PhaseKind { PK_P0 = 0, PK_P1, PK_DSA_IN, PK_DSA_Q, PK_DSA_SC, PK_DSA_ATT, PK_DSA_UV, PK_WO, PK_LN, PK_MOBA_IN, PK_MOBA_ATT, PK_MOBA_GATE, PK_MOBA_COMB };
__host__ __device__ constexpr int base_phase_kind(int ph, int& layer) {
    if (ph < 2) { layer = 0; return ph; }
    int p = ph - 2;
    for (int L = 0; L < DEPTH; ++L) {
        const int n = (L & 1) ? 6 : 7;
        if (p < n) { layer = L; if (L & 1) { constexpr int k[6] = {PK_MOBA_IN, PK_MOBA_GATE, PK_MOBA_ATT, PK_MOBA_COMB, PK_WO, PK_LN}; return k[p]; } else { constexpr int k[7] = {PK_DSA_IN, PK_DSA_Q, PK_DSA_SC, PK_DSA_ATT, PK_DSA_UV, PK_WO, PK_LN}; return k[p]; } }
        p -= n;
    }
    layer = 0; return -1;
}
constexpr int N_BASE_PHASES = 2 + 2 * 7 + 2 * 6;
__host__ __device__ constexpr int count_phases() { int n = 0; for (int p = 0; p < N_BASE_PHASES; ++p) { int l = 0; const int k = base_phase_kind(p, l); n += (MK_REP_KIND >= 0 && k == MK_REP_KIND) ? 2 : 1; } return n; }
constexpr int N_PHASES = count_phases();
__host__ __device__ constexpr int phase_kind(int ph, int& layer) {
    int n = 0;
    for (int p = 0; p < N_BASE_PHASES; ++p) { int l = 0; const int k = base_phase_kind(p, l); const int w = (MK_REP_KIND >= 0 && k == MK_REP_KIND) ? 2 : 1; if (ph < n + w) { layer = l; return k; } n += w; }
    layer = 0; return -1;
}

template <bool COOP>
__global__ void __launch_bounds__(512, 2) mk_fwd(Args a0) {
    extern __shared__ __attribute__((aligned(16))) unsigned char lds_raw[];
    const int wave0 = __builtin_amdgcn_readfirstlane((int)threadIdx.x >> 6);
    XcdBarrier xbar; xbar.bar = nullptr; xbar.x = 0; xbar.st = nullptr;
    if (COOP) {
        volatile LAS unsigned* st = (volatile LAS unsigned*)((LAS unsigned char*)lds_raw + LDS_PHASE);
        if (threadIdx.x < 2) st[threadIdx.x] = 0u;
        __syncthreads();
        xbar = xcd_barrier_post((unsigned*)(a0.ws + WS_BAR), st);
    }
    for (int ph = a0.ph_lo; ph < a0.ph_hi; ++ph) {
        const __attribute__((address_space(4))) Args* ka = (const __attribute__((address_space(4))) Args*)__builtin_amdgcn_kernarg_segment_ptr();
        asm volatile("" : "+s"(ka));
        KA a = *ka;
        unsigned ones_ = ~0u; asm volatile("" : "+s"(ones_));
        int tid_ = wave0 * 64 + (int)__builtin_amdgcn_mbcnt_hi(ones_, __builtin_amdgcn_mbcnt_lo(ones_, 0u)); asm volatile("" : "+v"(tid_));
        Ctx c;
        c.lds = (LAS unsigned char*)lds_raw;
        c.tid = tid_; c.lane = c.tid & 63; c.wave = __builtin_amdgcn_readfirstlane(c.tid >> 6);
        c.G = gridDim.x; { const int bx = blockIdx.x; c.vcu = (c.G % 8 == 0) ? (bx % 8) * (c.G / 8) + bx / 8 : bx; }
        c.gw = c.vcu * 8 + c.wave; c.NGW = c.G * 8;
        unsigned char* ws = a.ws;
        int layer = 0; const int kind = phase_kind(ph, layer); const int j = layer >> 1;
        unsigned char* wd = ws + WS_WD0 + (size_t)j * WD_SIZE; unsigned char* wm = ws + WS_WM0 + (size_t)j * WM_SIZE;
        pg8::StaticOrder so;
        switch (kind) {
        case PK_P0: if (EN(PK_P0)) { phase_p0(a, c); } break;
        case PK_P1: if (EN(PK_P1)) { phase_p1(a, c); } break;
        case PK_DSA_IN: if (EN(PK_DSA_IN)) {
            pg8::Gemm g{(const bf16_t*)(ws + WS_HB), (const bf16_t*)(wd + WD_WIN), S, DSA_INP, D, D, D, 0}; so.init(S, DSA_INP, c.G, (int)blockIdx.x);
            pg8::EpiDsaIn E{(bf16_t*)(ws + WU_CQ), (float*)(ws + WU_CKV), (bf16_t*)(ws + WU_KIDX), (float*)(ws + WS_WIDX), (bf16_t*)(ws + WS_SG), (float*)(ws + WS_SSQ)};
            pg8::gemm_phase(c.lds, c.tid, g, so, E); } break;
        case PK_DSA_Q: if (EN(PK_DSA_Q)) {
            pg8::Gemm g{(const bf16_t*)(ws + WU_CQ), (const bf16_t*)(wd + WD_W2), S, 6144, QR, QR, QR, 0}; so.init(S, 6144, c.G, (int)blockIdx.x);
            pg8::EpiDsaQ E{(bf16_t*)(ws + WU_QLAT), (bf16_t*)(ws + WU_QIDX), (const float*)(ws + WS_SSQ)};
            pg8::gemm_phase(c.lds, c.tid, g, so, E);
            dsa_ckv_norm(a, c, j); } break;
        case PK_DSA_SC: if (EN(PK_DSA_SC)) { phase_idx_scores(a, c); } break;
        case PK_DSA_ATT: if (EN(PK_DSA_ATT)) { phase_dsa_attn(a, c); } break;
        case PK_DSA_UV: if (EN(PK_DSA_UV)) {
            pg8::Gemm g{(const bf16_t*)(ws + WU_OLAT), (const bf16_t*)(wd + WD_WUV), S, D, 512, 4096, 512, 512}; so.init(S, D, c.G, (int)blockIdx.x);
            pg8::EpiUV E{(const bf16_t*)(ws + WS_SG), (bf16_t*)(ws + WS_GACT)};
            pg8::gemm_phase(c.lds, c.tid, g, so, E); } break;
        case PK_WO: if (EN(PK_WO)) {
            pg8::Gemm g{(const bf16_t*)(ws + WS_GACT), (const bf16_t*)((layer & 1) ? wm + WM_WO : wd + WD_WO), S, D, D, D, D, 0}; so.init(S, D, c.G, (int)blockIdx.x);
            pg8::EpiZ E{layer == 0 ? a.in[0] : (const float*)(ws + WS_X1), (const float*)(ws + WS_MOD) + (size_t)layer * 6144 + 4096, (float*)(ws + WS_Z)};
            pg8::gemm_phase(c.lds, c.tid, g, so, E); } break;
        case PK_LN: if (EN(PK_LN)) {
            phase_ln(a, c, layer); } break;
        case PK_MOBA_IN: if (EN(PK_MOBA_IN)) {
            pg8::Gemm g{(const bf16_t*)(ws + WS_HB), (const bf16_t*)(wm + WM_WIN), S, MOBA_IN, D, D, D, 0}; so.init(S, MOBA_IN, c.G, (int)blockIdx.x);
            pg8::EpiMobaIn E{(bf16_t*)(ws + WU_Q), (bf16_t*)(ws + WS_SG), (float*)(ws + WS_KMEAN) + (size_t)j * NH * 32 * HD};
            pg8::gemm_phase(c.lds, c.tid, g, so, E); } break;
        case PK_MOBA_GATE: if (EN(PK_MOBA_GATE)) { phase_moba_gate(a, c, j); } break;
        case PK_MOBA_ATT: if (EN(PK_MOBA_ATT)) { phase_moba_attn(a, c, j); } break;
        case PK_MOBA_COMB: if (EN(PK_MOBA_COMB)) { phase_moba_combine(a, c); } break;
        default: break;
        }
        if (COOP) { if (ph + 1 < a0.ph_hi) { if (ph == a0.ph_lo) cg::this_grid().sync(); else xcd_barrier(xbar); } }
    }
}

#if MK_CHECK
__global__ void __launch_bounds__(512, 1) chk_kernel(Args a0) {
    extern __shared__ __attribute__((aligned(16))) unsigned char lds_raw[];
    const __attribute__((address_space(4))) Args* ka = (const __attribute__((address_space(4))) Args*)__builtin_amdgcn_kernarg_segment_ptr();
    KA a = *ka;
    const int layer = a0.ph_lo, mode = a0.ph_hi;
    if (mode == 0) { if ((layer & 1) == 0) check_dsa(a, a0.ws, (LAS unsigned char*)lds_raw, (int)threadIdx.x, layer); else check_moba(a, a0.ws, (LAS unsigned char*)lds_raw, (int)threadIdx.x, layer); }
    else if (mode == 1) check_post(a, a0.ws, (LAS unsigned char*)lds_raw, (int)threadIdx.x, layer);
    else check_h0(a, a0.ws, (LAS unsigned char*)lds_raw, (int)threadIdx.x);
}
#endif
extern "C" void kernel_launch(void* const* d_in, const int* in_sizes, int n_in, void* d_out, int out_size, void* d_ws, size_t ws_size, hipStream_t stream) {
    static int grid = 0;
    if (grid == 0) {
        if (n_in != 16 || in_sizes[0] != S * D || out_size != S * D || ws_size < WS_END) {
            fprintf(stderr, "kernel_launch: unexpected shapes: n_in %d in0 %d out %d ws %zu (need %zu)\n", n_in, n_in > 0 ? in_sizes[0] : -1, out_size, ws_size, (size_t)WS_END); grid = -1; return; }
        int dev = 0, cus = 0, per_cu = 0;
        if (hipGetDevice(&dev) != hipSuccess || hipDeviceGetAttribute(&cus, hipDeviceAttributeMultiprocessorCount, dev) != hipSuccess) { grid = -1; return; }
        #if MK_ONE_LAUNCH
        const void* fn = (const void*)mk_fwd<true>;
#else
        const void* fn = (const void*)mk_fwd<false>;
#endif
        if (hipFuncSetAttribute(fn, hipFuncAttributeMaxDynamicSharedMemorySize, LDS_BYTES) != hipSuccess) { fprintf(stderr, "kernel_launch: hipFuncSetAttribute failed\n"); grid = -1; return; }
        if (hipOccupancyMaxActiveBlocksPerMultiprocessor(&per_cu, fn, 512, LDS_BYTES) != hipSuccess || per_cu < 1) { fprintf(stderr, "kernel_launch: occupancy query says %d blocks per CU\n", per_cu); per_cu = 1; }
        (void)hipGetLastError();
        grid = cus * 1;
    }
    if (grid < 0) return;
    (void)hipMemsetAsync(d_ws, 0, 65536, stream);
    Args a{};
    for (int i = 0; i < 16; ++i) a.in[i] = (const float*)d_in[i];
    a.out = (float*)d_out; a.ws = (unsigned char*)d_ws;
#if MK_ONE_LAUNCH
    a.ph_lo = 0; a.ph_hi = N_PHASES;
    void* params[] = {&a};
    hipError_t e = hipLaunchCooperativeKernel((const void*)mk_fwd<true>, dim3(grid), dim3(512), params, LDS_BYTES, stream);
    if (e != hipSuccess) fprintf(stderr, "kernel_launch: cooperative launch failed: %s (grid %d)\n", hipGetErrorString(e), grid);
#else
    for (int ph = 0; ph < N_PHASES; ++ph) {
#if MK_CHECK
        int layer_ = 0; const int kind_ = phase_kind(ph, layer_);
        { static bool once = false; if (!once) { once = true; (void)hipFuncSetAttribute((const void*)chk_kernel, hipFuncAttributeMaxDynamicSharedMemorySize, LDS_BYTES); } }
        if (kind_ == PK_LN) { a.ph_lo = layer_; a.ph_hi = 0; hipLaunchKernelGGL(chk_kernel, dim3(256), dim3(512), LDS_BYTES, stream, a); }
        if (ph == 2) { a.ph_lo = 0; a.ph_hi = 2; hipLaunchKernelGGL(chk_kernel, dim3(256), dim3(512), LDS_BYTES, stream, a); }
#endif
        a.ph_lo = ph; a.ph_hi = ph + 1;
        hipLaunchKernelGGL(mk_fwd<false>, dim3(grid), dim3(512), LDS_BYTES, stream, a);
#if MK_CHECK
        if (kind_ == PK_LN && layer_ < DEPTH - 1) { a.ph_lo = layer_; a.ph_hi = 1; hipLaunchKernelGGL(chk_kernel, dim3(256), dim3(512), LDS_BYTES, stream, a); }
#endif
    }
    const hipError_t le = hipPeekAtLastError();
    if (le != hipSuccess) fprintf(stderr, "kernel_launch: launch failed: %s\n", hipGetErrorName(le));
#endif
}
```
